# Optimizing an MI355X kernel written in HIP

```python
import jax, jax.numpy as jnp
from jax import lax
import numpy as np

D_MODEL = 1024
BATCH = 4
SEQ = 4096
DEPTH = 4

N_META = 16
D_FF = 4 * D_MODEL
D_CONV = D_MODEL // 2
CONV_WIDTH = 31
N_POOL_GROUPS = 4
POOL_WINDOWS = (2, 4, 8, 16)
D_POOL = D_MODEL // 2
POOL_GROUP_DIM = D_POOL // N_POOL_GROUPS
D_EVEN_IN = 2 * D_CONV + D_POOL
HGRN_HEAD_DIM = 128
HGRN_HEADS = D_MODEL // HGRN_HEAD_DIM
D_HGRN = HGRN_HEADS * HGRN_HEAD_DIM
CHUNK = 64
N_EVEN = (DEPTH + 1) // 2
N_ODD = DEPTH // 2
EPS = 1e-6

kernel_name = 'hybrid_conv_pool_hgrn2_trunk'


def _rmsnorm(x, g):
    xf = x.astype(jnp.float32)
    y = xf * lax.rsqrt(jnp.mean(xf * xf, axis=-1, keepdims=True) + EPS)
    return (y * g.astype(jnp.float32)).astype(x.dtype)


def _layernorm(x, g, b):
    xf = x.astype(jnp.float32)
    mu = jnp.mean(xf, axis=-1, keepdims=True)
    xc = xf - mu
    y = xc * lax.rsqrt(jnp.mean(xc * xc, axis=-1, keepdims=True) + EPS)
    return (y * g.astype(jnp.float32) + b.astype(jnp.float32)).astype(x.dtype)


def _conv_mixer(val, gate, conv_w, conv_b, ln_g, ln_b):
    a = val * jax.nn.sigmoid(gate)
    y = lax.conv_general_dilated(
        a, conv_w[:, None, :].astype(a.dtype), window_strides=(1,),
        padding=[(CONV_WIDTH - 1, 0)], dimension_numbers=('NWC', 'WIO', 'NWC'),
        feature_group_count=D_CONV) + conv_b
    return jax.nn.silu(_layernorm(y, ln_g, ln_b))


def _causal_window_mean(x, w):
    L = x.shape[1]
    cs = jnp.cumsum(x.astype(jnp.float32), axis=1)
    cs0 = jnp.pad(cs, ((0, 0), (1, 0), (0, 0)))
    lower = jnp.pad(cs0[:, :L + 1 - w], ((0, 0), (w - 1, 0), (0, 0)))
    count = jnp.minimum(jnp.arange(1, L + 1, dtype=jnp.float32), float(w))
    return ((cs - lower) / count[None, :, None]).astype(x.dtype)


def _pool_mixer(u, pool_w, pool_b, pool_scale):
    Bn, L, _ = u.shape
    ug = u.reshape(Bn, L, N_POOL_GROUPS, POOL_GROUP_DIM)
    pooled = jnp.stack([_causal_window_mean(ug[:, :, gi], w) for gi, w in enumerate(POOL_WINDOWS)], axis=2)
    y = jnp.einsum('blgc,gcd->blgd', pooled - ug, pool_w) + pool_b
    return y.reshape(Bn, L, D_POOL) * pool_scale


def _hgrn2_chunk_scan(q, k, v, logf):
    C = q.shape[3]
    causal = jnp.tril(jnp.ones((C, C), dtype=bool))

    def step(S, inp):
        qc, kc, vc, lfc = inp
        b = jnp.cumsum(lfc, axis=2)
        diff = b[:, :, :, None, :] - b[:, :, None, :, :]
        decay = jnp.exp(jnp.where(causal[:, :, None], diff, -jnp.inf))
        scores = jnp.einsum('bhtk,bhsk,bhtsk->bhts', qc, kc, decay)
        o = (jnp.einsum('bhts,bhsv->bhtv', scores, vc)
             + jnp.einsum('bhtk,bhkv->bhtv', qc * jnp.exp(b), S))
        b_last = b[:, :, -1:, :]
        S = (jnp.exp(b_last[:, :, 0, :])[..., None] * S
             + jnp.einsum('bhsk,bhsv->bhkv', kc * jnp.exp(b_last - b), vc))
        return S, o

    S0 = jnp.zeros((q.shape[1], q.shape[2], q.shape[4], v.shape[4]), jnp.float32)
    _, o = lax.scan(step, S0, (q, k, v, logf))
    return o


def _hgrn2_mixer(u, lb, gnorm_g):
    Bn, L, _ = u.shape
    q, f, i, g = jnp.split(u, 4, axis=-1)
    q = jax.nn.silu(q.astype(jnp.float32))
    forget = lb + (1.0 - lb) * jax.nn.sigmoid(f.astype(jnp.float32))
    k = 1.0 - forget
    logf = jnp.log(forget)
    v = i.astype(jnp.float32)
    pad = CHUNK - N_META
    Lp = L + pad
    n_chunks = Lp // CHUNK

    def to_chunks(t):
        t = jnp.pad(t, ((0, 0), (pad, 0), (0, 0)))
        t = t.reshape(Bn, n_chunks, CHUNK, HGRN_HEADS, HGRN_HEAD_DIM)
        return t.transpose(1, 0, 3, 2, 4)

    o = _hgrn2_chunk_scan(to_chunks(q), to_chunks(k), to_chunks(v), to_chunks(logf))
    o = o.transpose(1, 0, 3, 2, 4).reshape(Bn, Lp, HGRN_HEADS, HGRN_HEAD_DIM)[:, pad:]
    gh = g.reshape(Bn, L, HGRN_HEADS, HGRN_HEAD_DIM).astype(jnp.float32)
    o = _rmsnorm(o, gnorm_g) * jax.nn.silu(gh)
    return o.reshape(Bn, L, D_HGRN).astype(u.dtype)


def setup_inputs(seed: int = 0) -> dict:
    key = jax.random.key(seed)
    ks = jax.random.split(key, 24)
    f32 = jnp.float32
    nrm = lambda k, shape, s: jax.random.normal(k, shape, f32) * s
    return {
        'x': nrm(ks[0], (BATCH, SEQ, D_MODEL), 1.0),
        'meta_tokens': nrm(ks[1], (N_META, D_MODEL), 1.0),
        'mix_norm_g': 1.0 + nrm(ks[2], (DEPTH, D_MODEL), 0.02),
        'mlp_norm_g': 1.0 + nrm(ks[3], (DEPTH, D_MODEL), 0.02),
        'final_norm_g': 1.0 + nrm(ks[4], (D_MODEL,), 0.02),
        'ev_w_in': nrm(ks[5], (N_EVEN, D_MODEL, D_EVEN_IN), D_MODEL ** -0.5),
        'ev_conv_w': nrm(ks[6], (N_EVEN, CONV_WIDTH, D_CONV), CONV_WIDTH ** -0.5),
        'ev_conv_b': nrm(ks[7], (N_EVEN, D_CONV), 0.01),
        'ev_ln_g': 1.0 + nrm(ks[8], (N_EVEN, D_CONV), 0.02),
        'ev_ln_b': nrm(ks[9], (N_EVEN, D_CONV), 0.01),
        'ev_pool_w': nrm(ks[10], (N_EVEN, N_POOL_GROUPS, POOL_GROUP_DIM, POOL_GROUP_DIM), POOL_GROUP_DIM ** -0.5),
        'ev_pool_b': nrm(ks[11], (N_EVEN, N_POOL_GROUPS, POOL_GROUP_DIM), 0.01),
        'ev_pool_scale': 1.0 + nrm(ks[12], (N_EVEN, D_POOL), 0.02),
        'ev_w_out': nrm(ks[13], (N_EVEN, D_CONV + D_POOL, D_MODEL), (D_CONV + D_POOL) ** -0.5),
        'od_w_in': nrm(ks[14], (N_ODD, D_MODEL, 4 * D_HGRN), D_MODEL ** -0.5),
        'od_gnorm_g': 1.0 + nrm(ks[15], (N_ODD, HGRN_HEAD_DIM), 0.02),
        'od_w_out': nrm(ks[16], (N_ODD, D_HGRN, D_MODEL), D_HGRN ** -0.5),
        'lb_param': nrm(ks[17], (DEPTH, D_HGRN), 1.0),
        'mlp_w1': nrm(ks[18], (DEPTH, D_MODEL, D_FF), D_MODEL ** -0.5),
        'mlp_w2': nrm(ks[19], (DEPTH, D_FF, D_MODEL), D_FF ** -0.5),
    }


def reference(x, meta_tokens, mix_norm_g, mlp_norm_g, final_norm_g,
              ev_w_in, ev_conv_w, ev_conv_b, ev_ln_g, ev_ln_b,
              ev_pool_w, ev_pool_b, ev_pool_scale, ev_w_out,
              od_w_in, od_gnorm_g, od_w_out, lb_param, mlp_w1, mlp_w2):
    Bn = x.shape[0]
    meta = jnp.broadcast_to(meta_tokens[None].astype(x.dtype), (Bn, N_META, D_MODEL))
    h = jnp.concatenate([meta, x], axis=1)
    lb_all = jnp.cumsum(jax.nn.softmax(lb_param.astype(jnp.float32), axis=0), axis=0)
    lb_all = lb_all - lb_all[0]
    for layer in range(DEPTH):
        j = layer // 2
        n = _rmsnorm(h, mix_norm_g[layer])
        if layer % 2 == 0:
            u = n @ ev_w_in[j]
            val, gate, pin = jnp.split(u, [D_CONV, 2 * D_CONV], axis=-1)
            ya = _conv_mixer(val, gate, ev_conv_w[j], ev_conv_b[j], ev_ln_g[j], ev_ln_b[j])
            yb = _pool_mixer(pin, ev_pool_w[j], ev_pool_b[j], ev_pool_scale[j])
            h = h + jnp.concatenate([ya, yb], axis=-1) @ ev_w_out[j]
        else:
            u = n @ od_w_in[j]
            y = _hgrn2_mixer(u, lb_all[layer], od_gnorm_g[j])
            h = h + y @ od_w_out[j]
        n = _rmsnorm(h, mlp_norm_g[layer])
        h = h + jnp.square(jax.nn.relu(n @ mlp_w1[layer])) @ mlp_w2[layer]
    return _rmsnorm(h, final_norm_g)[:, N_META:]
```

```cpp
#include <hip/hip_runtime.h>
#include <hip/hip_cooperative_groups.h>
#include <cstdio>
#include <cstdint>
namespace cg = cooperative_groups;

#define LAS __attribute__((address_space(3)))
typedef unsigned short bf16_t;
typedef short bf16x8 __attribute__((ext_vector_type(8)));
typedef float f32x4 __attribute__((ext_vector_type(4)));
typedef float f32x2 __attribute__((ext_vector_type(2)));
typedef unsigned u32x4 __attribute__((ext_vector_type(4)));
typedef unsigned u32x2 __attribute__((ext_vector_type(2)));

constexpr int D = 1024, SEQ = 4096, NMETA = 16, MX = 16384, MR = 16400, DFF = 4096;
constexpr float EPS = 1e-6f;
constexpr int LDS_BYTES = 163840;

constexpr size_t MiB = 1u << 20;
constexpr size_t WS_WIN = 0, WS_WOUT = 8 * MiB, WS_W1 = 10 * MiB, WS_W2 = 18 * MiB, WS_WTMP = 26 * MiB  , WS_SSQ = 28 * MiB  , WS_MISC = 30 * MiB;
constexpr size_t MISC_LB = 0;
constexpr size_t MISC_BIASC = MISC_LB + 2 * 1024 * 4;
constexpr size_t MISC_BIASP = MISC_BIASC + 1024 * 4;
constexpr size_t MISC_HMETA = MISC_BIASP + 4 * 1024 * 4;
constexpr size_t MISC_BAR = MISC_HMETA + 16 * 1024 * 4;
constexpr size_t MISC_INPTR = MISC_BAR + 3456 * 4;
static_assert(MISC_INPTR + 32 * 8 <= MiB && 16 * (size_t)MR * 4 <= 2 * MiB, "misc");
constexpr size_t RB16 = (size_t)MR * 1024 * 2, RB32 = (size_t)MR * 1024 * 4;
constexpr size_t WS_HB = 31 * MiB;
constexpr int NCH = 2056;
constexpr size_t WS_UT = WS_HB + RB16;
constexpr size_t WS_DL = WS_WTMP;
constexpr size_t WS_Q = WS_UT + (size_t)NCH * 32768, WS_V = WS_Q + RB16, WS_SG = WS_V + RB16, WS_LOGF = WS_SG + RB16;
constexpr size_t WS_Y = WS_LOGF;
constexpr size_t WS_AR = WS_HB + RB16;
constexpr size_t WS_A = WS_AR, WS_PIN = WS_A + RB16 / 2, WS_CAT = WS_PIN + RB16 / 2;
constexpr size_t WS_M = WS_AR;
constexpr size_t WS_END = WS_LOGF + RB16;
static_assert(WS_END <= 256 * MiB && WS_M + 4 * RB16 <= 256 * MiB && (size_t)NCH * 512 <= 2 * MiB, "ws map");

typedef __bf16 bf16x2_t __attribute__((ext_vector_type(2)));
__device__ __forceinline__ unsigned cvt_pk_bf16(float lo, float hi) { const f32x2 v = {lo, hi}; const bf16x2_t r = __builtin_convertvector(v, bf16x2_t); return __builtin_bit_cast(unsigned, r); }
__device__ __forceinline__ float bf2f(unsigned short b) { return __uint_as_float(((unsigned)b) << 16); }
__device__ __forceinline__ float bflo(unsigned w) { return __uint_as_float(w << 16); }
__device__ __forceinline__ float bfhi(unsigned w) { return __uint_as_float(w & 0xffff0000u); }
__device__ __forceinline__ float wave_sum(float v) {
#pragma unroll
    for (int o = 32; o >= 1; o >>= 1) v += __shfl_xor(v, o);
    return v;
}
__device__ __forceinline__ float sigm(float x) { return 1.0f / (1.0f + __expf(-x)); }
__device__ __forceinline__ f32x4 sigm4(f32x4 x) { return (f32x4){sigm(x[0]), sigm(x[1]), sigm(x[2]), sigm(x[3])}; }
__device__ __forceinline__ bf16_t f2bf(float x) { return (bf16_t)(cvt_pk_bf16(x, 0.f) & 0xffffu); }
__device__ __forceinline__ u32x4 pack8(f32x4 a, f32x4 b) { u32x4 w; w.x = cvt_pk_bf16(a[0], a[1]); w.y = cvt_pk_bf16(a[2], a[3]); w.z = cvt_pk_bf16(b[0], b[1]); w.w = cvt_pk_bf16(b[2], b[3]); return w; }

__device__ __forceinline__ bf16x8 mk8(f32x4 a, f32x4 b) { const u32x4 w = pack8(a, b); return __builtin_bit_cast(bf16x8, w); }
__device__ __forceinline__ f32x4 exp4(f32x4 x) { return (f32x4){__expf(x[0]), __expf(x[1]), __expf(x[2]), __expf(x[3])}; }

namespace pg8 {
#define PG8_LAS __attribute__((address_space(3)))
constexpr int BM = 256, BK = 64, HALF = 128, HTB = HALF * BK * 2, STAGE_BYTES = 8 * HTB, NXCD = 8, WGM = 8;
__host__ __device__ __forceinline__ int lds_byte(int r, int c) { const int st = (r >> 4) * 2 + (c >> 5), rr = r & 15, cc = c & 31, ob = rr * 64 + cc * 2; return st * 1024 + (ob ^ (((ob >> 9) & 1) << 5)); }
__host__ __device__ __forceinline__ void stage_rc(int b, int& R, int& C) { const int st = b / 1024, sb = b % 1024, swz = sb ^ (((sb >> 9) & 1) << 5); R = (st >> 1) * 16 + swz / 64; C = (st & 1) * 32 + (swz % 64) / 2; }
__host__ __device__ __forceinline__ int perm32(int rho) { const int n = rho >> 4, i = rho & 15; return 8 * (i >> 2) + 4 * n + (i & 3); }
struct Unit { int pm, pn; };
struct Gemm { const bf16_t* A; const bf16_t* Bt; int M, N, K; };
struct StaticOrder {
    int nM, nN, nwg, G, c;
    __host__ __device__ void init(int M, int N, int G_, int c_) { nM = M / BM; nN = N / BM; nwg = nM * nN; G = G_; c = c_; }
    __host__ __device__ bool next(int i, Unit& u) const {
        const long L = (long)i * G + c; if (L >= nwg) return false;
        int wgid = (int)L; { const int q = nwg / NXCD, r = nwg % NXCD, xcd = wgid % NXCD, off = wgid / NXCD; wgid = (xcd < r ? xcd * (q + 1) : r * (q + 1) + (xcd - r) * q) + off; }
        const int nig = WGM * nN, gid = wgid / nig, fm = gid * WGM, gsz = (nM - fm) < WGM ? (nM - fm) : WGM;
        u.pm = fm + ((wgid % nig) % gsz); u.pn = (wgid % nig) / gsz; return true;
    }
    __device__ __forceinline__ void a_ready(const Unit&) const {}
    __device__ __forceinline__ void done(const Unit&) const {}
};

template <class Epi, class Sched, bool ALIGN_EPI = false, bool SP2 = false>
__device__ __forceinline__ void gemm_phase(PG8_LAS unsigned char* lds, const Gemm g, const Sched& S, const Epi& E) {
    int tid = threadIdx.x; asm volatile("" : "+v"(tid));
    const int wid = __builtin_amdgcn_readfirstlane(tid >> 6), lane = tid & 63, wr = wid >> 2, wc = wid & 3, fr = lane & 15, fq = lane >> 4;
    const int K = g.K, nt = K / BK;
    unsigned voffA[2], voffB[2];
#pragma unroll
    for (int i = 0; i < 2; ++i) { int R, C; stage_rc(tid * 16 + i * 8192, R, C); const int Rb = Epi::PERM ? ((R & ~31) + perm32(R & 31)) : R;
        voffA[i] = (unsigned)(R * K + C) * 2u; voffB[i] = (unsigned)(Rb * K + C) * 2u; }
    const size_t kstep = (size_t)(BK * 2);
    const size_t hstep = (size_t)HALF * K * 2;
    const size_t tstep = 2 * hstep;
    const unsigned ldsw = (unsigned)wid * 1024u;
    const int aoff = lds_byte(wr * 64 + fr, fq * 8), boff = lds_byte(wc * 32 + fr, fq * 8);
#define PG8_SA(b, h) (((b) * 2 + (h)) * HTB)
#define PG8_SB(b, h) ((4 + (b) * 2 + (h)) * HTB)
#define PG8_STAGE(bufoff, gbase, voff) do { _Pragma("unroll") for (int _i = 0; _i < 2; ++_i) \
        __builtin_amdgcn_global_load_lds((const unsigned*)((const char*)(gbase) + (voff)[_i]), (PG8_LAS unsigned*)(lds + (bufoff) + ldsw + _i * 8192), 16, 0, 0); } while (0)
#define PG8_LDA(dst, b, h) do { _Pragma("unroll") for (int m = 0; m < 4; ++m) _Pragma("unroll") for (int k = 0; k < 2; ++k) dst[m][k] = *(const PG8_LAS bf16x8*)(lds + PG8_SA(b, h) + aoff + m * 2048 + k * 1024); } while (0)
#define PG8_LDB(dst, b, h) do { _Pragma("unroll") for (int n = 0; n < 2; ++n) _Pragma("unroll") for (int k = 0; k < 2; ++k) dst[n][k] = *(const PG8_LAS bf16x8*)(lds + PG8_SB(b, h) + boff + n * 2048 + k * 1024); } while (0)
#define PG8_MMA(ai, bj, At, Bt) do { __builtin_amdgcn_s_setprio(1); _Pragma("unroll") for (int m = 0; m < 4; ++m) _Pragma("unroll") for (int n = 0; n < 2; ++n) _Pragma("unroll") for (int k = 0; k < 2; ++k) \
        acc[ai][bj][m][n] = __builtin_amdgcn_mfma_f32_16x16x32_bf16(Bt[n][k], At[m][k], acc[ai][bj][m][n], 0, 0, 0); __builtin_amdgcn_s_setprio(0); } while (0)
#define PG8_WAIT_V(n) asm volatile("s_waitcnt vmcnt(" #n ")" ::: "memory")
#define PG8_WAIT_L(n) asm volatile("s_waitcnt lgkmcnt(" #n ")" ::: "memory")
#define PG8_BAR __builtin_amdgcn_s_barrier()
#define PG8_SCHED __builtin_amdgcn_sched_barrier(0)
    Unit cur, nxt; int ui = 0;
    if (!S.next(0, cur)) return;
    f32x4 acc[2][2][4][2];
#pragma unroll
    for (int a = 0; a < 2; ++a)
#pragma unroll
        for (int b = 0; b < 2; ++b)
#pragma unroll
            for (int m = 0; m < 4; ++m)
#pragma unroll
                for (int n = 0; n < 2; ++n) acc[a][b][m][n] = (f32x4){0.f, 0.f, 0.f, 0.f};
    bf16x8 At[4][2], B0[2][2], B1[2][2];
    const char* cA = (const char*)g.A + (size_t)cur.pm * tstep; const char* cB = (const char*)g.Bt + (size_t)cur.pn * tstep;
    S.a_ready(cur);
    if constexpr (SP2) {
        PG8_STAGE(PG8_SB(0, 0), cB, voffB); PG8_STAGE(PG8_SB(0, 1), cB + hstep, voffB); PG8_STAGE(PG8_SA(0, 0), cA, voffA); PG8_STAGE(PG8_SA(0, 1), cA + hstep, voffA);
        if (wr == 1) PG8_BAR;
        PG8_WAIT_V(2); PG8_BAR;
        PG8_STAGE(PG8_SB(1, 0), cB + kstep, voffB); PG8_STAGE(PG8_SA(1, 0), cA + kstep, voffA); PG8_STAGE(PG8_SB(1, 1), cB + hstep + kstep, voffB);
        PG8_WAIT_V(6); PG8_BAR;
    } else {
        PG8_STAGE(PG8_SB(0, 0), cB, voffB); PG8_STAGE(PG8_SA(0, 0), cA, voffA); PG8_STAGE(PG8_SB(0, 1), cB + hstep, voffB); PG8_STAGE(PG8_SA(0, 1), cA + hstep, voffA);
        if (wr == 1) PG8_BAR;
        PG8_WAIT_V(4); PG8_BAR;
        PG8_STAGE(PG8_SB(1, 0), cB + kstep, voffB); PG8_STAGE(PG8_SA(1, 0), cA + kstep, voffA); PG8_STAGE(PG8_SB(1, 1), cB + hstep + kstep, voffB);
        PG8_WAIT_V(6); PG8_BAR;
    }
    for (;;) {
        const bool has_next = S.next(ui + 1, nxt);
        const char* nA = has_next ? (const char*)g.A + (size_t)nxt.pm * tstep : cA; const char* nB = has_next ? (const char*)g.Bt + (size_t)nxt.pn * tstep : cB;
        for (int t = 0; t < nt; t += 2) {
            const bool last = (t == nt - 2);
            const char* a1 = cA + (size_t)(t + 1) * kstep;
            const char* a2 = last ? nA : cA + (size_t)(t + 2) * kstep; const char* b2 = last ? nB : cB + (size_t)(t + 2) * kstep;
            const char* a3 = a2 + kstep; const char* b3 = b2 + kstep;
            if (last && has_next) S.a_ready(nxt);
            if constexpr (SP2) {
            PG8_LDB(B0, 0, 0); PG8_LDB(B1, 0, 1); PG8_SCHED; PG8_LDA(At, 0, 0); PG8_STAGE(PG8_SA(1, 1), a1 + hstep, voffA);
            PG8_WAIT_V(8); PG8_WAIT_L(0); PG8_BAR; PG8_MMA(0, 0, At, B0); PG8_MMA(0, 1, At, B1); PG8_BAR; PG8_SCHED;
            PG8_LDA(At, 0, 1); PG8_STAGE(PG8_SB(0, 0), b2, voffB); PG8_STAGE(PG8_SB(0, 1), b2 + hstep, voffB); PG8_STAGE(PG8_SA(0, 0), a2, voffA);
            PG8_WAIT_V(8); PG8_WAIT_L(0); PG8_BAR; PG8_MMA(1, 0, At, B0); PG8_MMA(1, 1, At, B1); PG8_BAR; PG8_SCHED;
            PG8_LDB(B0, 1, 0); PG8_LDB(B1, 1, 1); PG8_SCHED; PG8_LDA(At, 1, 0); PG8_STAGE(PG8_SA(0, 1), a2 + hstep, voffA);
            PG8_WAIT_V(8); PG8_WAIT_L(0); PG8_BAR; PG8_MMA(0, 0, At, B0); PG8_MMA(0, 1, At, B1); PG8_BAR; PG8_SCHED;
            PG8_LDA(At, 1, 1); PG8_STAGE(PG8_SB(1, 0), b3, voffB); PG8_STAGE(PG8_SB(1, 1), b3 + hstep, voffB); PG8_STAGE(PG8_SA(1, 0), a3, voffA);
            PG8_WAIT_V(8); PG8_WAIT_L(0); PG8_BAR; PG8_MMA(1, 0, At, B0); PG8_MMA(1, 1, At, B1); PG8_BAR; PG8_SCHED;
            } else {
            PG8_LDB(B0, 0, 0); PG8_SCHED; PG8_LDA(At, 0, 0); PG8_STAGE(PG8_SA(1, 1), a1 + hstep, voffA);
            PG8_WAIT_L(8); PG8_BAR; PG8_WAIT_L(0); PG8_MMA(0, 0, At, B0); PG8_BAR; PG8_SCHED;
            PG8_LDB(B1, 0, 1); PG8_STAGE(PG8_SB(0, 0), b2, voffB);
            PG8_BAR; PG8_WAIT_L(0); PG8_MMA(0, 1, At, B1); PG8_BAR;
            PG8_LDA(At, 0, 1); PG8_STAGE(PG8_SA(0, 0), a2, voffA);
            PG8_BAR; PG8_WAIT_L(0); PG8_MMA(1, 0, At, B0); PG8_BAR; PG8_SCHED;
            PG8_STAGE(PG8_SB(0, 1), b2 + hstep, voffB);
            PG8_WAIT_V(6); PG8_BAR; PG8_MMA(1, 1, At, B1); PG8_BAR;
            PG8_LDB(B0, 1, 0); PG8_SCHED; PG8_LDA(At, 1, 0); PG8_STAGE(PG8_SA(0, 1), a2 + hstep, voffA);
            PG8_WAIT_L(8); PG8_BAR; PG8_WAIT_L(0); PG8_MMA(0, 0, At, B0); PG8_BAR; PG8_SCHED;
            PG8_LDB(B1, 1, 1); PG8_STAGE(PG8_SB(1, 0), b3, voffB);
            PG8_BAR; PG8_WAIT_L(0); PG8_MMA(0, 1, At, B1); PG8_BAR;
            PG8_LDA(At, 1, 1); PG8_STAGE(PG8_SA(1, 0), a3, voffA);
            PG8_BAR; PG8_WAIT_L(0); PG8_MMA(1, 0, At, B0); PG8_BAR; PG8_SCHED;
            PG8_STAGE(PG8_SB(1, 1), b3 + hstep, voffB);
            PG8_WAIT_V(6); PG8_BAR; PG8_MMA(1, 1, At, B1); PG8_BAR;
            }
        }
        if constexpr (ALIGN_EPI) { if (wr == 0) PG8_BAR; }
        E(acc, cur, wr, wc, fr, fq);
        if (!has_next) break;
#pragma unroll
        for (int a = 0; a < 2; ++a)
#pragma unroll
            for (int b = 0; b < 2; ++b)
#pragma unroll
                for (int m = 0; m < 4; ++m)
#pragma unroll
                    for (int n = 0; n < 2; ++n) acc[a][b][m][n] = (f32x4){0.f, 0.f, 0.f, 0.f};
        cur = nxt; cA = nA; cB = nB; ++ui;
        if constexpr (ALIGN_EPI) { if (wr == 1) PG8_BAR; }
    }
    PG8_WAIT_V(0);
    if constexpr (!ALIGN_EPI) { if (wr == 0) PG8_BAR; }
    PG8_BAR;
#undef PG8_SA
#undef PG8_SB
#undef PG8_STAGE
#undef PG8_LDA
#undef PG8_LDB
#undef PG8_MMA
#undef PG8_WAIT_V
#undef PG8_WAIT_L
#undef PG8_BAR
#undef PG8_SCHED
}
}

__device__ __forceinline__ float row_rinv(const float* ssq, int r, int fq) {
    const float* q = ssq + (size_t)(4 * fq) * MR + r;
    float s = (q[0] + q[MR]) + (q[2 * MR] + q[3 * MR]);
    s += __shfl_xor(s, 16); s += __shfl_xor(s, 32);
    return rsqrtf(s * (1.0f / D) + EPS);
}
struct RowEvenIn {
    bf16_t* Abuf; bf16_t* Pin; const float* ssq;
    __device__ __forceinline__ float prep(int r, int fq) const { return row_rinv(ssq, r, fq); }
    __device__ __forceinline__ void row(int r, int pn, int wc, int fq, f32x4 v00, f32x4 v01, f32x4 v10, f32x4 v11, float rinv) const {
        if (pn < 4) {
            const int col = 128 * pn + 32 * wc + 8 * fq;
            const f32x4 a0 = (v00 * rinv) * sigm4(v10 * rinv), a1 = (v01 * rinv) * sigm4(v11 * rinv);
            *(u32x4*)(Abuf + (size_t)r * 512 + col) = pack8(a0, a1);
        } else {
            const int col = (pn - 4) * 256 + 32 * wc + 8 * fq;
            *(u32x4*)(Pin + (size_t)r * 512 + col) = pack8(v00 * rinv, v01 * rinv);
            *(u32x4*)(Pin + (size_t)r * 512 + col + 128) = pack8(v10 * rinv, v11 * rinv);
        }
    }
};
struct RowOddIn {
    bf16_t* Q; bf16_t* LOGF; bf16_t* V; bf16_t* SG; const float* ssq; const float* lb;
    __device__ __forceinline__ float prep(int r, int fq) const { return row_rinv(ssq, r, fq); }
    __device__ __forceinline__ void row(int r, int pn, int wc, int fq, f32x4 v00, f32x4 v01, f32x4 v10, f32x4 v11, float rinv) const {
        const int type = pn >> 2, col = (pn & 3) * 256 + 32 * wc + 8 * fq;
        const size_t o = (size_t)r * 1024 + col;
        v00 = v00 * rinv; v01 = v01 * rinv; v10 = v10 * rinv; v11 = v11 * rinv;
        if (type == 0) {
            *(u32x4*)(Q + o) = pack8(v00 * sigm4(v00), v01 * sigm4(v01)); *(u32x4*)(Q + o + 128) = pack8(v10 * sigm4(v10), v11 * sigm4(v11));
        } else if (type == 1) {
            const f32x4 l00 = *(const f32x4*)(lb + col), l01 = *(const f32x4*)(lb + col + 4), l10 = *(const f32x4*)(lb + col + 128), l11 = *(const f32x4*)(lb + col + 132);
            f32x4 f00 = l00 + (1.0f - l00) * sigm4(v00), f01 = l01 + (1.0f - l01) * sigm4(v01), f10 = l10 + (1.0f - l10) * sigm4(v10), f11 = l11 + (1.0f - l11) * sigm4(v11);
#pragma unroll
            for (int j = 0; j < 4; ++j) { f00[j] = __logf(f00[j]); f01[j] = __logf(f01[j]); f10[j] = __logf(f10[j]); f11[j] = __logf(f11[j]); }
            *(u32x4*)(LOGF + o) = pack8(f00, f01); *(u32x4*)(LOGF + o + 128) = pack8(f10, f11);
        } else if (type == 2) {
            *(u32x4*)(V + o) = pack8(v00, v01); *(u32x4*)(V + o + 128) = pack8(v10, v11);
        } else {
            *(u32x4*)(SG + o) = pack8(v00 * sigm4(v00), v01 * sigm4(v01)); *(u32x4*)(SG + o + 128) = pack8(v10 * sigm4(v10), v11 * sigm4(v11));
        }
    }
};
struct RowRes {
    bf16_t* hb; float* ssq; const float* bias; float gain;
    __device__ __forceinline__ float prep(int, int) const { return 0.f; }
    __device__ __forceinline__ void row(int r, int pn, int wc, int fq, f32x4 v00, f32x4 v01, f32x4 v10, f32x4 v11, float) const {
        const int col = 256 * pn + 32 * wc + 8 * fq;
        bf16_t* hp = hb + (size_t)r * D + col;
        const u32x4 h0 = *(const u32x4*)hp, h1 = *(const u32x4*)(hp + 128);
        if (bias) { v00 += *(const f32x4*)(bias + col); v01 += *(const f32x4*)(bias + col + 4); v10 += *(const f32x4*)(bias + col + 128); v11 += *(const f32x4*)(bias + col + 132); }
        v00 = v00 * gain + (f32x4){bflo(h0.x), bfhi(h0.x), bflo(h0.y), bfhi(h0.y)}; v01 = v01 * gain + (f32x4){bflo(h0.z), bfhi(h0.z), bflo(h0.w), bfhi(h0.w)};
        v10 = v10 * gain + (f32x4){bflo(h1.x), bfhi(h1.x), bflo(h1.y), bfhi(h1.y)}; v11 = v11 * gain + (f32x4){bflo(h1.z), bfhi(h1.z), bflo(h1.w), bfhi(h1.w)};
        *(u32x4*)hp = pack8(v00, v01); *(u32x4*)(hp + 128) = pack8(v10, v11);
        const f32x4 q = v00 * v00 + v01 * v01 + v10 * v10 + v11 * v11;
        float s = (q[0] + q[1]) + (q[2] + q[3]);
        s += __shfl_xor(s, 16); s += __shfl_xor(s, 32);
        if (fq == 0) ssq[(size_t)(pn * 4 + wc) * MR + r] = s;
    }
};
struct RowMlpUp {
    bf16_t* Mb; const float* ssq;
    __device__ __forceinline__ float prep(int r, int fq) const { return row_rinv(ssq, r, fq); }
    __device__ __forceinline__ void row(int r, int pn, int wc, int fq, f32x4 v00, f32x4 v01, f32x4 v10, f32x4 v11, float rinv) const {
        const int col = 256 * pn + 32 * wc + 8 * fq;
        const f32x4 z = (f32x4){0.f, 0.f, 0.f, 0.f};
        v00 = __builtin_elementwise_max(v00 * rinv, z); v01 = __builtin_elementwise_max(v01 * rinv, z); v10 = __builtin_elementwise_max(v10 * rinv, z); v11 = __builtin_elementwise_max(v11 * rinv, z);
        __builtin_nontemporal_store(pack8(v00 * v00, v01 * v01), (u32x4*)(Mb + (size_t)r * DFF + col)); __builtin_nontemporal_store(pack8(v10 * v10, v11 * v11), (u32x4*)(Mb + (size_t)r * DFF + col + 128));
    }
};
template <class Row> struct EpiAdapt {
    static constexpr bool PERM = true, AFTER_DRAIN = false;
    Row R;
    __device__ __forceinline__ void operator()(const f32x4 (&acc)[2][2][4][2], const pg8::Unit& u, int wr, int wc, int fr, int fq) const {
        asm volatile("" ::: "memory");
#pragma unroll
        for (int ai = 0; ai < 2; ++ai)
#pragma unroll
            for (int m = 0; m < 4; ++m) { const int r = u.pm * 256 + ai * 128 + wr * 64 + m * 16 + fr; R.row(r, u.pn, wc, fq, acc[ai][0][m][0], acc[ai][0][m][1], acc[ai][1][m][0], acc[ai][1][m][1], R.prep(r, fq)); }
    }
};

template <class Row, int K>
__device__ __forceinline__ void skinny_unit(LAS unsigned char* lds, const bf16_t* A16, const bf16_t* Bt, int pn, int wc, const Row& R) {
    int tid = threadIdx.x; asm volatile("" : "+v"(tid));
    const int wid = __builtin_amdgcn_readfirstlane(tid >> 6), lane = tid & 63, fr = lane & 15, fq = lane >> 4;
    constexpr int KS = K / 8, NG = KS / 128;
    float rinv = 0.f; if (wid == 0) rinv = R.prep(MX + fr, fq);
    f32x4 acc[4];
#pragma unroll
    for (int t = 0; t < 4; ++t) acc[t] = (f32x4){0.f, 0.f, 0.f, 0.f};
    const bf16_t* ap = A16 + (size_t)fr * K + wid * KS + fq * 8;
    const bf16_t* bp = Bt + (size_t)(256 * pn + 32 * wc + 8 * (fr >> 2) + (fr & 3)) * K + wid * KS + fq * 8;
    bf16x8 af[1][4], bf[1][4][4];
#define SK_LOAD(buf, g) do { _Pragma("unroll") for (int st = 0; st < 4; ++st) { af[buf][st] = *(const bf16x8*)(ap + (g) * 128 + st * 32); \
        _Pragma("unroll") for (int t = 0; t < 4; ++t) bf[buf][st][t] = *(const bf16x8*)(bp + (size_t)(128 * (t >> 1) + 4 * (t & 1)) * K + (g) * 128 + st * 32); } } while (0)
    SK_LOAD(0, 0);
#pragma unroll
    for (int g = 0; g < NG; ++g) {
        if (g > 0) SK_LOAD(0, g);
#pragma unroll
        for (int st = 0; st < 4; ++st)
#pragma unroll
            for (int t = 0; t < 4; ++t) acc[t] = __builtin_amdgcn_mfma_f32_16x16x32_bf16(bf[0][st][t], af[0][st], acc[t], 0, 0, 0);
    }
#undef SK_LOAD
    LAS float* red = (LAS float*)lds;
#pragma unroll
    for (int t = 0; t < 4; ++t)
#pragma unroll
        for (int j = 0; j < 4; ++j) red[(wid * 16 + t * 4 + j) * 64 + lane] = acc[t][j];
    __syncthreads();
    if (wid == 0) {
        f32x4 v[4];
#pragma unroll
        for (int t = 0; t < 4; ++t)
#pragma unroll
            for (int j = 0; j < 4; ++j) { float sm = 0.f;
#pragma unroll
                for (int w = 0; w < 8; ++w) sm += red[(w * 16 + t * 4 + j) * 64 + lane];
                v[t][j] = sm; }
        R.row(MX + fr, pn, wc, fq, v[0], v[1], v[2], v[3], rinv);
    }
    __syncthreads();
}

__device__ __forceinline__ int glu_rowmap(int n0) { if (n0 < 512) return 256 * (n0 >> 7) + (n0 & 127); if (n0 < 1024) { const int n1 = n0 - 512; return 256 * (n1 >> 7) + 128 + (n1 & 127); } return n0; }
__device__ __forceinline__ int conv_job(LAS unsigned char* lds, int base, const float* src, int ldn, int K, int N, const float* gain, bf16_t* dst, int dst_ld, int koff, bool glu, int G = gridDim.x, int blk = blockIdx.x) {
    LAS float* tile = (LAS float*)lds;
    int tid = threadIdx.x; asm volatile("" : "+v"(tid));
    const int nT = N >> 6, nitems = (K >> 6) * nT;
    int first = (blk - base) % G; if (first < 0) first += G;
    for (int it = first; it < nitems; it += G) {
        const int kt = it / nT, ntile = it - kt * nT, k0 = kt * 64, n0 = ntile * 64, drow0 = glu ? glu_rowmap(n0) : n0;
#pragma unroll
        for (int i = 0; i < 2; ++i) { const int e = tid + 512 * i, kk = e >> 4, n4 = (e & 15) * 4;
            f32x4 x = *(const f32x4*)(src + (size_t)(k0 + kk) * ldn + n0 + n4); if (gain) x = x * gain[k0 + kk];
            tile[kk * 65 + n4 + 0] = x[0]; tile[kk * 65 + n4 + 1] = x[1]; tile[kk * 65 + n4 + 2] = x[2]; tile[kk * 65 + n4 + 3] = x[3]; }
        __syncthreads();
        { const int n = tid >> 3, kc = (tid & 7) * 8; u32x4 w;
          w.x = cvt_pk_bf16(tile[(kc + 0) * 65 + n], tile[(kc + 1) * 65 + n]); w.y = cvt_pk_bf16(tile[(kc + 2) * 65 + n], tile[(kc + 3) * 65 + n]);
          w.z = cvt_pk_bf16(tile[(kc + 4) * 65 + n], tile[(kc + 5) * 65 + n]); w.w = cvt_pk_bf16(tile[(kc + 6) * 65 + n], tile[(kc + 7) * 65 + n]);
          *(u32x4*)(dst + (size_t)(drow0 + n) * dst_ld + koff + k0 + kc) = w; }
        __syncthreads();
    }
    return base + nitems;
}

struct Params { const float* in[20]; float* out; unsigned char* ws; };
enum { I_X = 0, I_META, I_MIXG, I_MLPG, I_FING, I_EVWIN, I_CONVW, I_CONVB, I_LNG, I_LNB, I_POOLW, I_POOLB, I_POOLS, I_EVWOUT, I_ODWIN, I_GNORM, I_ODWOUT, I_LBP, I_W1, I_W2 };

__device__ __forceinline__ int seqrow(int b, int p) { return p < NMETA ? MX + p : b * SEQ + (p - NMETA); }

#define XB_TMO      128
#define XB_XCNT(j)  (256  + 64 * (j))
#define XB_XSUB(j)  (1280 + 64 * (j))
#define XB_XGEN(j)  (2304 + 64 * (j))
#define XB_TOP      3328
#define XB_TOPGEN   3392
#define XCD_BAR_WORDS 3456
#define XB_SPIN_CAP (1u << 18)

__device__ __forceinline__ unsigned xb_ld(unsigned* p)              { return __hip_atomic_load(p, __ATOMIC_RELAXED, __HIP_MEMORY_SCOPE_AGENT); }
__device__ __forceinline__ unsigned xb_add(unsigned* p, unsigned v) { return __hip_atomic_fetch_add(p, v, __ATOMIC_RELAXED, __HIP_MEMORY_SCOPE_AGENT); }
__device__ __forceinline__ unsigned xb_xcc_id() { return (unsigned)__builtin_amdgcn_s_getreg((3 << 11) | 20) & 0xFu; }
#define XB_SPIN(cond, bar) do { unsigned _sp = 0; while (cond) { __builtin_amdgcn_s_sleep(1); \
    if ((++_sp & 255u) == 0u) { if (xb_ld(&(bar)[XB_TMO])) break; if (_sp > XB_SPIN_CAP) { atomicAdd(&(bar)[XB_TMO], 1u); break; } } } } while (0)

struct XcdBarrier {
    unsigned* bar; unsigned x;
    volatile LAS unsigned* st;
};

__device__ __forceinline__ XcdBarrier xcd_barrier_post(unsigned* bar, volatile LAS unsigned* st) {
    XcdBarrier b; b.bar = bar; b.x = xb_xcc_id(); b.st = st;
    if (threadIdx.x == 0) (void)xb_add(&bar[XB_XCNT(b.x)], 1u);
    return b;
}
__device__ __forceinline__ void xcd_barrier_complete(unsigned* bar, unsigned x, unsigned& nloc, unsigned& nx) {
    const unsigned G = gridDim.x * gridDim.y * gridDim.z;
    unsigned sum, cnt, mine, sp = 0u;
    for (;;) {
        sum = 0u; cnt = 0u; mine = 0u;
#pragma unroll
        for (unsigned j = 0; j < 16; ++j) { const unsigned c = xb_ld(&bar[XB_XCNT(j)]); sum += c; cnt += (c > 0u) ? 1u : 0u; }
        mine = xb_ld(&bar[XB_XCNT(x)]);
        if (sum == G) break;
        __builtin_amdgcn_s_sleep(1);
        if ((++sp & 255u) == 0u) { if (xb_ld(&bar[XB_TMO])) break; if (sp > XB_SPIN_CAP) { atomicAdd(&bar[XB_TMO], 1u); break; } }
    }
    nloc = mine > 0u ? mine : 1u; nx = cnt > 0u ? cnt : 1u;
}

__device__ __forceinline__ void xcd_barrier(const XcdBarrier& b) {
    asm volatile("s_waitcnt vmcnt(0)" ::: "memory");
    __syncthreads();
    if (threadIdx.x == 0) {
        unsigned* bar = b.bar;
        __builtin_amdgcn_s_waitcnt(0);
        unsigned nloc = b.st[0], nx = b.st[1];
        if (nloc == 0u) { xcd_barrier_complete(bar, b.x, nloc, nx); b.st[0] = nloc; b.st[1] = nx; }
        const unsigned old = xb_add(&bar[XB_XSUB(b.x)], 1u);
        const unsigned gen = old / nloc;
        if (old + 1u == (gen + 1u) * nloc) {
            __builtin_amdgcn_fence(__ATOMIC_RELEASE, "agent");
            asm volatile("s_waitcnt vmcnt(0)" ::: "memory");
            const unsigned og = xb_add(&bar[XB_TOP], 1u);
            const unsigned tg = og / nx;
            if (og + 1u == (tg + 1u) * nx) xb_add(&bar[XB_TOPGEN], 1u);
            else XB_SPIN(xb_ld(&bar[XB_TOPGEN]) == tg, bar);
            __builtin_amdgcn_fence(__ATOMIC_ACQUIRE, "agent");
            xb_add(&bar[XB_XGEN(b.x)], 1u);
            asm volatile("s_waitcnt vmcnt(0)" ::: "memory");
        } else {
            XB_SPIN(xb_ld(&bar[XB_XGEN(b.x)]) == gen, bar);
            __builtin_amdgcn_fence(__ATOMIC_ACQUIRE, "agent");
            asm volatile("s_waitcnt vmcnt(0)" ::: "memory");
        }
    }
    __syncthreads();
}

#define PHASE_VARS \
    unsigned char* ws = p.ws; asm volatile("" : "+s"(ws)); \
    int tid = threadIdx.x; asm volatile("" : "+v"(tid)); \
    const int lane = tid & 63, wid = __builtin_amdgcn_readfirstlane(tid >> 6); \
    const float* const* IN = (const float* const*)(ws + WS_MISC + MISC_INPTR); (void)IN; \
    const int gw = bid * 8 + wid, gt = bid * 512 + tid; (void)gw; (void)gt; (void)lane; \
    bf16_t* WIN = (bf16_t*)(ws + WS_WIN); bf16_t* WOUT = (bf16_t*)(ws + WS_WOUT); bf16_t* W1 = (bf16_t*)(ws + WS_W1); bf16_t* W2 = (bf16_t*)(ws + WS_W2); \
    float* WTMP = (float*)(ws + WS_WTMP); \
    float* SSQ = (float*)(ws + WS_SSQ); float* LB = (float*)(ws + WS_MISC + MISC_LB); float* BIASC = (float*)(ws + WS_MISC + MISC_BIASC); float* BIASP = (float*)(ws + WS_MISC + MISC_BIASP); float* HMETA = (float*)(ws + WS_MISC + MISC_HMETA); (void)BIASP; \
    bf16_t* HB = (bf16_t*)(ws + WS_HB); bf16_t* UT = (bf16_t*)(ws + WS_UT); float* DL = (float*)(ws + WS_DL); (void)UT; (void)DL; \
    bf16_t* QB = (bf16_t*)(ws + WS_Q); bf16_t* VB = (bf16_t*)(ws + WS_V); bf16_t* SG = (bf16_t*)(ws + WS_SG); bf16_t* LOGF = (bf16_t*)(ws + WS_LOGF); bf16_t* YB = (bf16_t*)(ws + WS_Y); \
    bf16_t* AB = (bf16_t*)(ws + WS_A); bf16_t* PIN = (bf16_t*)(ws + WS_PIN); bf16_t* CAT = (bf16_t*)(ws + WS_CAT); bf16_t* MB = (bf16_t*)(ws + WS_M); \
    (void)WIN; (void)WOUT; (void)W1; (void)W2; (void)WTMP; (void)SSQ; (void)LB; (void)BIASC; (void)HMETA; (void)HB; (void)QB; (void)VB; (void)SG; (void)LOGF; (void)YB; (void)AB; (void)PIN; (void)CAT; (void)MB; \
    const int j = l >> 1; const bool odd = (l & 1) != 0; const int sb = G - 1 - bid; (void)j; (void)odd; (void)sb; \
    const float* ssq_mix = SSQ; float* ssq_mlp = SSQ; float* ssq_next = SSQ; (void)ssq_mix; (void)ssq_mlp; (void)ssq_next;


#ifndef PROBE_MLP
#define PROBE_MLP 0
#endif
#ifndef PROBE_MIX
#define PROBE_MIX 0
#endif
#define PASSC_ITEMS(wlo_, whi_) do { \
                for (int wi = (wlo_) + gw; wi < (whi_); wi += NGW) { \
                    int it, tp; if (wi < 4096) { it = wi >> 1; tp = wi & 1; } else { it = 2048 + (wi - 4096); tp = 1; } \
                    const int cidx = it >> 3, hc = (it & 7) * 128; const bool meta = (cidx == 256); \
                    const int lr0 = 32 * tp + fr, lr1 = lr0 + 16; \
                    const int gr0 = meta ? (lr0 >= 48 ? MX + lr0 - 48 : -1) : cidx * 64 + lr0, gr1 = meta ? (lr1 >= 48 ? MX + lr1 - 48 : -1) : cidx * 64 + lr1; \
                    f32x4 acc0[8], acc1[8]; \
                    _Pragma("unroll") for (int vb = 0; vb < 8; ++vb) { acc0[vb] = (f32x4){0.f, 0.f, 0.f, 0.f}; acc1[vb] = acc0[vb]; } \
                    if (!meta) { \
                        const bf16_t* sp = UT + (size_t)it * 16384 + (size_t)fr * 128 + 8 * fq; \
                        const bf16_t* qp0 = QB + (size_t)gr0 * 1024 + hc + 8 * fq; const bf16_t* qp1 = QB + (size_t)gr1 * 1024 + hc + 8 * fq; \
                        bf16x8 qf0[4], qf1[4]; \
                        _Pragma("unroll") for (int kk = 0; kk < 4; ++kk) { qf0[kk] = *(const bf16x8*)(qp0 + 32 * kk); qf1[kk] = *(const bf16x8*)(qp1 + 32 * kk); } \
                        _Pragma("unroll") for (int vb = 0; vb < 8; ++vb) { \
                            _Pragma("unroll") for (int kk = 0; kk < 4; ++kk) { const bf16x8 sf = *(const bf16x8*)(sp + vb * 16 * 128 + 32 * kk); \
                                acc0[vb] = __builtin_amdgcn_mfma_f32_16x16x32_bf16(sf, qf0[kk], acc0[vb], 0, 0, 0); acc1[vb] = __builtin_amdgcn_mfma_f32_16x16x32_bf16(sf, qf1[kk], acc1[vb], 0, 0, 0); } \
                            if (vb & 1) asm volatile("" ::: "memory"); } \
                    } \
                    _Pragma("unroll") for (int u = 0; u < 2; ++u) { const int gr = u ? gr1 : gr0; \
                        if (gr >= 0) { \
                            float ss = 0.f; f32x4 o[8]; \
                            _Pragma("unroll") for (int vb = 0; vb < 8; ++vb) { const u32x2 oi = *(const u32x2*)(VB + (size_t)gr * 1024 + hc + 16 * vb + 4 * fq); \
                                o[vb] = (u ? acc1[vb] : acc0[vb]) + (f32x4){bflo(oi.x), bfhi(oi.x), bflo(oi.y), bfhi(oi.y)}; const f32x4 q2 = o[vb] * o[vb]; ss += (q2[0] + q2[1]) + (q2[2] + q2[3]); } \
                            ss += __shfl_xor(ss, 16); ss += __shfl_xor(ss, 32); \
                            const float rn = rsqrtf(ss * (1.0f / 128.0f) + EPS); \
                            _Pragma("unroll") for (int vb = 0; vb < 8; ++vb) { const int col = 16 * vb + 4 * fq; const u32x2 sg = *(const u32x2*)(SG + (size_t)gr * 1024 + hc + col); \
                                const f32x4 y = o[vb] * rn * *(const f32x4*)(gg + col) * (f32x4){bflo(sg.x), bfhi(sg.x), bflo(sg.y), bfhi(sg.y)}; \
                                u32x2 w; w.x = cvt_pk_bf16(y[0], y[1]); w.y = cvt_pk_bf16(y[2], y[3]); *(u32x2*)(YB + (size_t)gr * 1024 + hc + col) = w; } } } \
                } \
} while (0)
__global__ void __launch_bounds__(512, 2) fwd(Params p) {
    extern __shared__ __attribute__((aligned(16))) unsigned char lds_raw[];
    cg::grid_group grid = cg::this_grid();
    LAS unsigned char* lds = (LAS unsigned char*)lds_raw;
    const int bid = blockIdx.x, G = gridDim.x, NGW = G * 8, NGT = G * 512;
    volatile LAS unsigned* bar_st = (volatile LAS unsigned*)(lds + LDS_BYTES - 16);
    if (threadIdx.x < 4) bar_st[threadIdx.x] = 0u;
    if (bid == 0) {
        if (threadIdx.x == 0) { const float** tb = (const float**)(p.ws + WS_MISC + MISC_INPTR);
#pragma unroll
            for (int i = 0; i < 20; ++i) tb[i] = p.in[i];
            tb[20] = p.out; } }
    __syncthreads();
    const XcdBarrier xbar = xcd_barrier_post((unsigned*)(p.ws + WS_MISC + MISC_BAR), bar_st);
#define GRID_BAR() xcd_barrier(xbar)
    {
        const int l = 0; PHASE_VARS
        for (int r = gw; r < MR; r += NGW) {
            const float* src = (r < MX) ? p.in[I_X] + (size_t)r * D : p.in[I_META] + (size_t)(r - MX) * D;
            float s = 0.f;
#pragma unroll
            for (int i = 0; i < 4; ++i) { const int c = lane * 4 + 256 * i; const f32x4 v = __builtin_nontemporal_load((const f32x4*)(src + c));
                u32x2 w; w.x = cvt_pk_bf16(v[0], v[1]); w.y = cvt_pk_bf16(v[2], v[3]); *(u32x2*)(HB + (size_t)r * D + c) = w;
                s += (v[0] * v[0] + v[1] * v[1]) + (v[2] * v[2] + v[3] * v[3]); }
            s = wave_sum(s); if (lane < 16) SSQ[(size_t)lane * MR + r] = (lane == 0) ? s : 0.f;
        }
        if (gt < 1024) {
            const float* lp = p.in[I_LBP]; const float a0 = lp[gt], a1 = lp[1024 + gt], a2 = lp[2048 + gt], a3 = lp[3072 + gt];
            const float mx = fmaxf(fmaxf(a0, a1), fmaxf(a2, a3)); const float e0 = expf(a0 - mx), e1 = expf(a1 - mx), e2 = expf(a2 - mx), e3 = expf(a3 - mx); const float inv = 1.0f / (e0 + e1 + e2 + e3);
            LB[gt] = e1 * inv; LB[1024 + gt] = (e1 + e2 + e3) * inv;
        }
        conv_job(lds, 0, p.in[I_EVWIN], 1536, 1024, 1536, p.in[I_MIXG], WIN, 1024, 0, true);
    }
    GRID_BAR();
    if (p.ws == nullptr) grid.sync();

    for (int l = 0; l < 4; ++l) {
        if ((l & 1) == 0) {
            PHASE_VARS
            {
                const int fr = lane & 15, fq = lane >> 4;
                for (int tile = gw; tile < 4 * 9 * 64; tile += NGW) {
                    const int g = tile / 576, rem = tile - g * 576, ct = rem >> 6, nt = rem & 63;
                    const float* pw = (ct < 8) ? IN[I_POOLW] + ((size_t)(j * 4 + g) * 128 + 16 * ct + fr) * 128 : IN[I_POOLB] + (size_t)(j * 4 + g) * 128;
                    const bool live = (ct < 8) || (fr == 0);
                    const float* sc = IN[I_POOLS] + j * 512 + g * 128;
                    const float* wo = IN[I_EVWOUT] + ((size_t)j * 1024 + 512 + g * 128) * 1024 + 16 * nt + fr;
                    f32x4 acc = (f32x4){0.f, 0.f, 0.f, 0.f};
#pragma unroll
                    for (int kk = 0; kk < 4; ++kk) { const int d0 = 32 * kk + 8 * fq;
                        f32x4 a0 = *(const f32x4*)(pw + d0) * *(const f32x4*)(sc + d0), a1 = *(const f32x4*)(pw + d0 + 4) * *(const f32x4*)(sc + d0 + 4);
                        if (!live) { a0 = (f32x4){0.f, 0.f, 0.f, 0.f}; a1 = a0; }
                        f32x4 b0, b1;
#pragma unroll
                        for (int e = 0; e < 4; ++e) { b0[e] = wo[(size_t)(d0 + e) * 1024]; b1[e] = wo[(size_t)(d0 + 4 + e) * 1024]; }
                        acc = __builtin_amdgcn_mfma_f32_16x16x32_bf16(mk8(a0, a1), mk8(b0, b1), acc, 0, 0, 0); }
                    if (ct < 8) {
#pragma unroll
                        for (int jj = 0; jj < 4; ++jj) WTMP[(size_t)(g * 128 + 16 * ct + 4 * fq + jj) * 1024 + 16 * nt + fr] = acc[jj];
                    } else if (fq == 0) BIASP[g * 1024 + 16 * nt + fr] = acc[0];
                }
            }
            RowEvenIn R{AB, PIN, ssq_mix};
            if (sb < 1536 / 64) skinny_unit<decltype(R), 1024>(lds, HB + (size_t)MX * D, WIN, sb >> 2, sb & 3, R);
            pg8::Gemm g{HB, WIN, MX, 1536, 1024}; pg8::StaticOrder S; S.init(MX, 1536, G, bid); EpiAdapt<RowEvenIn> E{R};
            pg8::gemm_phase<EpiAdapt<RowEvenIn>, pg8::StaticOrder, true, true>(lds, g, S, E);
            if (G == 256 && bid >= 128) {
                int base = 0;
                base = conv_job(lds, base, IN[I_W1] + (size_t)l * 1024 * 4096, 4096, 1024, 4096, IN[I_MLPG] + l * 1024, W1, 1024, 0, false, 128, bid - 128);
                base = conv_job(lds, base, IN[I_W2] + (size_t)l * 4096 * 1024, 1024, 4096, 1024, nullptr, W2, 4096, 0, false, 128, bid - 128);
            }
        } else {
            PHASE_VARS
            if ((bid & 1) == 0) conv_job(lds, 0, IN[I_W2] + (size_t)l * 4096 * 1024, 1024, 4096, 1024, nullptr, W2, 4096, 0, false);
            RowOddIn R{QB, LOGF, VB, SG, ssq_mix, LB + j * 1024};
            if (sb < 4096 / 64) skinny_unit<decltype(R), 1024>(lds, HB + (size_t)MX * D, WIN, sb >> 2, sb & 3, R);
            pg8::Gemm g{HB, WIN, MX, 4096, 1024}; pg8::StaticOrder S; S.init(MX, 4096, G, bid); EpiAdapt<RowOddIn> E{R};
            pg8::gemm_phase<EpiAdapt<RowOddIn>, pg8::StaticOrder, true, true>(lds, g, S, E);
            if ((bid & 1) != 0) conv_job(lds, 0, IN[I_W2] + (size_t)l * 4096 * 1024, 1024, 4096, 1024, nullptr, W2, 4096, 0, false);
        }
        GRID_BAR();
        {
            PHASE_VARS
            if (!odd && gt < 1024) BIASC[gt] = (BIASP[gt] + BIASP[1024 + gt]) + (BIASP[2048 + gt] + BIASP[3072 + gt]);
            const int skipb = (G == 256) ? (odd ? 8 : 1) : 0, Gc = G - skipb, bc = bid - skipb;
            if (bc >= 0) {
            int base = 0;
            if (!odd) { base = conv_job(lds, base, IN[I_EVWOUT] + (size_t)j * 1024 * 1024, 1024, 512, 1024, nullptr, WOUT, 1024, 0, false, Gc, bc);
                        base = conv_job(lds, base, WTMP, 1024, 512, 1024, nullptr, WOUT, 1024, 512, false, Gc, bc);
                        }
            else base = conv_job(lds, base, IN[I_ODWOUT] + (size_t)j * 1024 * 1024, 1024, 1024, 1024, nullptr, WOUT, 1024, 0, false, Gc, bc);
            if (odd || G != 256) base = conv_job(lds, base, IN[I_W1] + (size_t)l * 1024 * 4096, 4096, 1024, 4096, IN[I_MLPG] + l * 1024, W1, 1024, 0, false, Gc, bc);
            if (!odd && G != 256) base = conv_job(lds, base, IN[I_W2] + (size_t)l * 4096 * 1024, 1024, 4096, 1024, nullptr, W2, 4096, 0, false, Gc, bc);
            }
        }
        if ((l & 1) == 0) {
            PHASE_VARS
            LAS unsigned char* TA = lds;
            LAS unsigned char* TW = lds + 96256;
            { const float* cwg = IN[I_CONVW] + (size_t)j * 31 * 512;
              for (int ch = wid; ch < 62; ch += 8) { const int tap = ch >> 1, half = ch & 1;
                  __builtin_amdgcn_global_load_lds((const unsigned*)(cwg + tap * 512 + lane * 8 + half * 4), (LAS unsigned*)(TW + ch * 1024), 16, 0, 0); } }
            for (int bi = bid; bi < 257; bi += G) {
                const int b = (bi < 256) ? (bi >> 6) : 0, tb0 = (bi < 256) ? NMETA + ((bi & 63) << 6) : 0, ntok = (bi < 256) ? 64 : 16;
                for (int r = wid; r < 94; r += 8) { const int pp = tb0 - 30 + r;
                    if (pp >= 0) __builtin_amdgcn_global_load_lds((const unsigned*)(AB + (size_t)seqrow(b, pp) * 512 + lane * 8), (LAS unsigned*)(TA + r * 1024), 16, 0, 0);
                    else *(LAS u32x4*)(TA + r * 1024 + lane * 16) = (u32x4){0u, 0u, 0u, 0u}; }
                asm volatile("s_waitcnt vmcnt(0) lgkmcnt(0)" ::: "memory"); __syncthreads();
                if (8 * wid < ntok) {
                    const int c0 = lane * 8;
                    f32x4 ya0[4], ya1[4], yb0[4], yb1[4], w0[4], w1[4];
                    { const f32x4 cb0 = *(const f32x4*)(IN[I_CONVB] + j * 512 + c0), cb1 = *(const f32x4*)(IN[I_CONVB] + j * 512 + c0 + 4);
#pragma unroll
                      for (int o = 0; o < 4; ++o) { ya0[o] = cb0; ya1[o] = cb1; yb0[o] = cb0; yb1[o] = cb1; w0[o] = (f32x4){0.f, 0.f, 0.f, 0.f}; w1[o] = w0[o]; } }
#pragma unroll 1
                    for (int i0 = 0; i0 < 36; i0 += 4) {
#pragma unroll
                        for (int ii = 0; ii < 4; ++ii) {
                            const int i = i0 + ii;
                            f32x4 t0_ = (f32x4){0.f, 0.f, 0.f, 0.f}, t1_ = t0_;
                            if (i <= 30) { t0_ = *(LAS f32x4*)(TW + (2 * i) * 1024 + lane * 16); t1_ = *(LAS f32x4*)(TW + (2 * i + 1) * 1024 + lane * 16); }
                            w0[ii] = t0_; w1[ii] = t1_;
                            f32x4 a0 = (f32x4){0.f, 0.f, 0.f, 0.f}, a1 = a0, b0 = a0, b1 = a0;
                            if (i < 34) { const u32x4 av = *(LAS u32x4*)(TA + (8 * wid + i) * 1024 + lane * 16), bv = *(LAS u32x4*)(TA + (8 * wid + 4 + i) * 1024 + lane * 16);
                                a0 = (f32x4){bflo(av.x), bfhi(av.x), bflo(av.y), bfhi(av.y)}; a1 = (f32x4){bflo(av.z), bfhi(av.z), bflo(av.w), bfhi(av.w)};
                                b0 = (f32x4){bflo(bv.x), bfhi(bv.x), bflo(bv.y), bfhi(bv.y)}; b1 = (f32x4){bflo(bv.z), bfhi(bv.z), bflo(bv.w), bfhi(bv.w)}; }
#pragma unroll
                            for (int o = 0; o < 4; ++o) { ya0[o] += w0[(ii - o) & 3] * a0; ya1[o] += w1[(ii - o) & 3] * a1; yb0[o] += w0[(ii - o) & 3] * b0; yb1[o] += w1[(ii - o) & 3] * b1; }
                        }
                    }
                    const float* lg = IN[I_LNG] + j * 512 + c0; const float* lbp = IN[I_LNB] + j * 512 + c0;
                    const f32x4 g0 = *(const f32x4*)lg, g1 = *(const f32x4*)(lg + 4), bb0 = *(const f32x4*)lbp, bb1 = *(const f32x4*)(lbp + 4);
#pragma unroll
                    for (int o = 0; o < 8; ++o) {
                        const int r = seqrow(b, tb0 + 8 * wid + o);
                        const f32x4 y0 = (o < 4) ? ya0[o & 3] : yb0[o & 3], y1 = (o < 4) ? ya1[o & 3] : yb1[o & 3];
                        const float s_ = ((y0[0] + y0[1]) + (y0[2] + y0[3])) + ((y1[0] + y1[1]) + (y1[2] + y1[3]));
                        const float mu = wave_sum(s_) * (1.0f / 512.0f);
                        const f32x4 d0 = y0 - mu, d1 = y1 - mu; const f32x4 qq = d0 * d0 + d1 * d1;
                        const float var = wave_sum((qq[0] + qq[1]) + (qq[2] + qq[3])) * (1.0f / 512.0f);
                        const float rs = rsqrtf(var + EPS);
                        f32x4 z0 = d0 * rs * g0 + bb0, z1 = d1 * rs * g1 + bb1;
                        z0 = z0 * sigm4(z0); z1 = z1 * sigm4(z1);
                        *(u32x4*)(CAT + (size_t)r * 1024 + c0) = pack8(z0, z1);
                    }
                }
                __syncthreads();
                for (int r = wid; r < 79; r += 8) { const int pp = tb0 - 15 + r;
                    if (pp >= 0) __builtin_amdgcn_global_load_lds((const unsigned*)(PIN + (size_t)seqrow(b, pp) * 512 + lane * 8), (LAS unsigned*)(TA + r * 1024), 16, 0, 0);
                    else *(LAS u32x4*)(TA + r * 1024 + lane * 16) = (u32x4){0u, 0u, 0u, 0u}; }
                asm volatile("s_waitcnt vmcnt(0) lgkmcnt(0)" ::: "memory"); __syncthreads();
                for (int wi = wid; wi < (ntok >> 3) * 4; wi += 8) {
                    const int q = wi >> 2, g = wi & 3, pw = 2 << g, c = g * 128 + 2 * lane;
                    f32x2 pv[23];
#pragma unroll
                    for (int i = 0; i < 23; ++i) { pv[i] = (f32x2){0.f, 0.f};
                        if (i >= 16 - pw) { const unsigned w = *(LAS unsigned*)(TA + (8 * q + i) * 1024 + g * 256 + lane * 4); pv[i] = (f32x2){bflo(w), bfhi(w)}; } }
#pragma unroll
                    for (int o = 0; o < 8; ++o) { f32x2 sm = (f32x2){0.f, 0.f};
#pragma unroll
                        for (int ii = 0; ii < 16; ++ii) if (ii < pw) sm += pv[15 + o - ii];
                        const int t = tb0 + 8 * q + o; const float inv = 1.0f / (float)((t + 1 < pw) ? (t + 1) : pw);
                        const f32x2 d = sm * inv - pv[15 + o];
                        *(unsigned*)(CAT + (size_t)seqrow(b, t) * 1024 + 512 + c) = cvt_pk_bf16(d[0], d[1]); }
                }
                __syncthreads();
            }
        } else {
            PHASE_VARS
            LAS float* Lb = (LAS float*)lds;
            LAS bf16_t* Lkb = (LAS bf16_t*)(lds + 33792);
            LAS bf16_t* Lq = (LAS bf16_t*)(lds + 51200);
            LAS bf16_t* LvT = (LAS bf16_t*)(lds + 68608);
            LAS float* Lraw = (LAS float*)(lds + 87040);
            LAS bf16_t* LP = (LAS bf16_t*)(lds + 87040);
            LAS bf16_t* LKdT = (LAS bf16_t*)(lds + 120832);
            const int fr = lane & 15, fq = lane >> 4;
            u32x4 pl[2], pq[2], pvv[2];
#define PA_ROW(lr_) (meta_ ? ((lr_) >= 48 ? MX + (lr_) - 48 : -1) : cidx_ * 64 + (lr_))
#define PA_ISSUE_L(it_, tid) do { const int cidx_ = (it_) >> 3, hc_ = ((it_) & 7) * 128; const bool meta_ = (cidx_ == 256); \
                _Pragma("unroll") for (int i = 0; i < 2; ++i) { const int e = tid + 512 * i, lr = e >> 4, c8 = (e & 15) * 8; const int gr = PA_ROW(lr); \
                    pl[i] = (u32x4){0u, 0u, 0u, 0u}; if (gr >= 0) pl[i] = *(const u32x4*)(LOGF + (size_t)gr * 1024 + hc_ + c8); } } while (0)
#define PA_ISSUE_QV(it_, tid) do { const int cidx_ = (it_) >> 3, hc_ = ((it_) & 7) * 128; const bool meta_ = (cidx_ == 256); \
                _Pragma("unroll") for (int i = 0; i < 2; ++i) { const int e = tid + 512 * i; \
                    { const int lr = e >> 4, c8 = (e & 15) * 8; const int gr = PA_ROW(lr); pq[i] = (u32x4){0u, 0u, 0u, 0u}; if (gr >= 0) pq[i] = *(const u32x4*)(QB + (size_t)gr * 1024 + hc_ + c8); } \
                    { const int lr = e & 63, c8 = (e >> 6) * 8; const int gr = PA_ROW(lr); pvv[i] = (u32x4){0u, 0u, 0u, 0u}; if (gr >= 0) pvv[i] = *(const u32x4*)(VB + (size_t)gr * 1024 + hc_ + c8); } } } while (0)
            if (bid < NCH) PA_ISSUE_L(bid, tid);
            for (int it = bid; it < NCH; it += G) {
                int tl = tid; asm volatile("" : "+v"(tl));
                const int lanel = tl & 63, frl = lanel & 15, fql = lanel >> 4, widl = __builtin_amdgcn_readfirstlane(tl >> 6);
                PA_ISSUE_QV(it, tl);
                const int cidx = it >> 3, hc = (it & 7) * 128; const bool meta = (cidx == 256);
#pragma unroll
                for (int i = 0; i < 2; ++i) { const int e = tl + 512 * i, lr = e >> 4, c8 = (e & 15) * 8; const u32x4 lw = pl[i];
                    *(LAS f32x4*)(Lraw + lr * 132 + c8) = (f32x4){bflo(lw.x), bfhi(lw.x), bflo(lw.y), bfhi(lw.y)}; *(LAS f32x4*)(Lraw + lr * 132 + c8 + 4) = (f32x4){bflo(lw.z), bfhi(lw.z), bflo(lw.w), bfhi(lw.w)}; }
                __syncthreads();
                if (it + G < NCH) PA_ISSUE_L(it + G, tl);
                { const int col = tl & 127, sc = tl >> 7; float pre = 0.f, tot = 0.f;
#pragma unroll 4
                  for (int r = 0; r < 64; ++r) { const float x = Lraw[r * 132 + col]; tot += x; if (r < 16 * sc) pre = tot; }
                  float run = pre;
#pragma unroll
                  for (int r = 0; r < 16; ++r) { const int row = 16 * sc + r; const float lf = Lraw[row * 132 + col]; run += lf; Lb[row * 132 + col] = run;
                      const float kf = 1.0f - __expf(lf); Lkb[row * 136 + col] = f2bf(kf); LKdT[col * 72 + row] = f2bf(kf * __expf(tot - run)); }
                  if (sc == 3) DL[(size_t)it * 128 + col] = __expf(tot); }
#pragma unroll
                for (int i = 0; i < 2; ++i) { const int e = tl + 512 * i;
                    { const int lr = e >> 4, c8 = (e & 15) * 8; *(LAS u32x4*)(Lq + lr * 136 + c8) = pq[i]; }
                    { const int lr = e & 63, c8 = (e >> 6) * 8; const u32x4 vv = pvv[i];
                      LvT[(c8 + 0) * 72 + lr] = (bf16_t)(vv.x & 0xffffu); LvT[(c8 + 1) * 72 + lr] = (bf16_t)(vv.x >> 16); LvT[(c8 + 2) * 72 + lr] = (bf16_t)(vv.y & 0xffffu); LvT[(c8 + 3) * 72 + lr] = (bf16_t)(vv.y >> 16);
                      LvT[(c8 + 4) * 72 + lr] = (bf16_t)(vv.z & 0xffffu); LvT[(c8 + 5) * 72 + lr] = (bf16_t)(vv.z >> 16); LvT[(c8 + 6) * 72 + lr] = (bf16_t)(vv.w & 0xffffu); LvT[(c8 + 7) * 72 + lr] = (bf16_t)(vv.w >> 16); } }
                __syncthreads();
#pragma unroll
                for (int i = 0; i < 2; ++i) { const int e = tl + 512 * i, lr = e >> 4, c8 = (e & 15) * 8; const int gr = meta ? (lr >= 48 ? MX + lr - 48 : -1) : cidx * 64 + lr;
                    if (gr >= 0) { const u32x4 qv = *(LAS u32x4*)(Lq + lr * 136 + c8); const f32x4 e0 = exp4(*(LAS f32x4*)(Lb + lr * 132 + c8)), e1 = exp4(*(LAS f32x4*)(Lb + lr * 132 + c8 + 4));
                        const f32x4 a0 = (f32x4){bflo(qv.x), bfhi(qv.x), bflo(qv.y), bfhi(qv.y)} * e0, a1 = (f32x4){bflo(qv.z), bfhi(qv.z), bflo(qv.w), bfhi(qv.w)} * e1;
                        *(u32x4*)(QB + (size_t)gr * 1024 + hc + c8) = pack8(a0, a1); } }
                for (int idx = widl; idx < 10; idx += 8) {
                    const int i = idx >= 6 ? 3 : (idx >= 3 ? 2 : (idx >= 1 ? 1 : 0)), jb = idx - (i * (i + 1)) / 2;
                    const int t = 16 * i + frl, s_ = 16 * jb + frl;
                    f32x4 acc = (f32x4){0.f, 0.f, 0.f, 0.f};
#pragma unroll 1
                    for (int kk = 0; kk < 4; ++kk) { const int c = 32 * kk + 8 * fql;
                        f32x4 B0 = (f32x4){0.f, 0.f, 0.f, 0.f}, B1 = B0; if (i > 0) { B0 = *(LAS f32x4*)(Lb + (16 * i - 1) * 132 + c); B1 = *(LAS f32x4*)(Lb + (16 * i - 1) * 132 + c + 4); }
                        const f32x4 bt0 = *(LAS f32x4*)(Lb + t * 132 + c), bt1 = *(LAS f32x4*)(Lb + t * 132 + c + 4), bs0 = *(LAS f32x4*)(Lb + s_ * 132 + c), bs1 = *(LAS f32x4*)(Lb + s_ * 132 + c + 4);
                        const u32x4 qv = *(LAS u32x4*)(Lq + t * 136 + c), kv = *(LAS u32x4*)(Lkb + s_ * 136 + c);
                        const f32x4 m80 = (f32x4){80.f, 80.f, 80.f, 80.f};
                        const f32x4 qa0 = (f32x4){bflo(qv.x), bfhi(qv.x), bflo(qv.y), bfhi(qv.y)} * exp4(bt0 - B0), qa1 = (f32x4){bflo(qv.z), bfhi(qv.z), bflo(qv.w), bfhi(qv.w)} * exp4(bt1 - B1);
                        const f32x4 ka0 = (f32x4){bflo(kv.x), bfhi(kv.x), bflo(kv.y), bfhi(kv.y)} * exp4(__builtin_elementwise_min(B0 - bs0, m80)), ka1 = (f32x4){bflo(kv.z), bfhi(kv.z), bflo(kv.w), bfhi(kv.w)} * exp4(__builtin_elementwise_min(B1 - bs1, m80));
                        acc = __builtin_amdgcn_mfma_f32_16x16x32_bf16(mk8(ka0, ka1), mk8(qa0, qa1), acc, 0, 0, 0); }
                    if (i == jb) {
#pragma unroll
                        for (int jj = 0; jj < 4; ++jj) if (4 * fql + jj > frl) acc[jj] = 0.f; }
                    u32x2 w; w.x = cvt_pk_bf16(acc[0], acc[1]); w.y = cvt_pk_bf16(acc[2], acc[3]);
                    *(LAS u32x2*)(LP + t * 72 + 16 * jb + 4 * fql) = w;
                }
                if (widl >= 2) { const int u = widl - 2, i = u < 3 ? 0 : (u < 5 ? 1 : 2), jb = u < 3 ? u + 1 : (u < 5 ? u - 1 : 3);
                    *(LAS u32x2*)(LP + (16 * i + frl) * 72 + 16 * jb + 4 * fql) = (u32x2){0u, 0u}; }
                __syncthreads();
                {
#pragma unroll
                    for (int i = 0; i < 4; ++i) {
                        f32x4 acc = (f32x4){0.f, 0.f, 0.f, 0.f};
#pragma unroll
                        for (int ss = 0; ss < 2; ++ss) if (ss == 0 || i >= 2) {
                            const bf16x8 a = *(LAS bf16x8*)(LvT + (16 * widl + frl) * 72 + 32 * ss + 8 * fql), bb = *(LAS bf16x8*)(LP + (16 * i + frl) * 72 + 32 * ss + 8 * fql);
                            acc = __builtin_amdgcn_mfma_f32_16x16x32_bf16(a, bb, acc, 0, 0, 0); }
                        const int lr = 16 * i + frl; const int gr = meta ? (lr >= 48 ? MX + lr - 48 : -1) : cidx * 64 + lr;
                        if (gr >= 0) { u32x2 w; w.x = cvt_pk_bf16(acc[0], acc[1]); w.y = cvt_pk_bf16(acc[2], acc[3]); *(u32x2*)(VB + (size_t)gr * 1024 + hc + 16 * widl + 4 * fql) = w; }
                    }
                    bf16_t* ut = UT + (size_t)it * 16384;
                    const bf16x8 v0 = *(LAS bf16x8*)(LvT + (16 * widl + frl) * 72 + 8 * fql), v1 = *(LAS bf16x8*)(LvT + (16 * widl + frl) * 72 + 32 + 8 * fql);
#pragma unroll
                    for (int kb = 0; kb < 8; ++kb) {
                        const bf16x8 a0 = *(LAS bf16x8*)(LKdT + (16 * kb + frl) * 72 + 8 * fql), a1 = *(LAS bf16x8*)(LKdT + (16 * kb + frl) * 72 + 32 + 8 * fql);
                        f32x4 acc = (f32x4){0.f, 0.f, 0.f, 0.f};
                        acc = __builtin_amdgcn_mfma_f32_16x16x32_bf16(a0, v0, acc, 0, 0, 0); acc = __builtin_amdgcn_mfma_f32_16x16x32_bf16(a1, v1, acc, 0, 0, 0);
                        u32x2 w; w.x = cvt_pk_bf16(acc[0], acc[1]); w.y = cvt_pk_bf16(acc[2], acc[3]);
                        *(u32x2*)(ut + (16 * widl + frl) * 128 + 16 * kb + 4 * fql) = w;
                    }
                }
                __syncthreads();
            }
#undef PA_ISSUE_L
#undef PA_ISSUE_QV
#undef PA_ROW
        }
        GRID_BAR();
        if (l & 1) {
            {
                PHASE_VARS
                for (int rep = 0; rep < 1 + ((PROBE_MIX >> 3) & 1); ++rep) {
                const bool dry = (rep < ((PROBE_MIX >> 3) & 1)) && (((size_t)p.ws & 1) == 0);
                for (int g2 = gt; g2 < 32 * 4096; g2 += NGT) {
                    const int e4 = g2 & 4095, bh = g2 >> 12, b = bh >> 3, h = bh & 7, k4 = (e4 & 31) * 4;
                    const u32x2 m0 = *(const u32x2*)(UT + (size_t)(2048 + h) * 16384 + e4 * 4);
                    f32x4 S = (f32x4){bflo(m0.x), bfhi(m0.x), bflo(m0.y), bfhi(m0.y)};
                    for (int n0 = 0; n0 < 64; n0 += 16) {
                        u32x2 U[16]; f32x4 d[16];
#pragma unroll
                        for (int u = 0; u < 16; ++u) { const size_t item = (size_t)((b * 64 + n0 + u) * 8 + h); U[u] = *(const u32x2*)(UT + item * 16384 + e4 * 4); d[u] = *(const f32x4*)(DL + item * 128 + k4); }
#pragma unroll
                        for (int u = 0; u < 16; ++u) { const size_t item = (size_t)((b * 64 + n0 + u) * 8 + h);
                            u32x2 w; w.x = cvt_pk_bf16(S[0], S[1]); w.y = cvt_pk_bf16(S[2], S[3]); if (dry) w = U[u]; *(u32x2*)(UT + item * 16384 + e4 * 4) = w;
                            S = d[u] * S + (f32x4){bflo(U[u].x), bfhi(U[u].x), bflo(U[u].y), bfhi(U[u].y)}; }
                    }
                }
                }
            }
            GRID_BAR();
            {
                PHASE_VARS
                const int fr = lane & 15, fq = lane >> 4;
                const float* gg = IN[I_GNORM] + j * 128;
                PASSC_ITEMS(0, 4104);
            }
            GRID_BAR();
        }
        {
            PHASE_VARS
            const bf16_t* A = odd ? YB : CAT;
            RowRes R{HB, ssq_mlp, odd ? nullptr : BIASC, 1.0f};
            if (sb < 1024 / 64) skinny_unit<decltype(R), 1024>(lds, A + (size_t)MX * D, WOUT, sb >> 2, sb & 3, R);
            pg8::Gemm g{A, WOUT, MX, 1024, 1024}; pg8::StaticOrder S; S.init(MX, 1024, G, bid); EpiAdapt<RowRes> E{R};
            pg8::gemm_phase<EpiAdapt<RowRes>, pg8::StaticOrder, true, true>(lds, g, S, E);
        }
        GRID_BAR();
        for (int rep = 0; rep < 1 + PROBE_MLP; ++rep) {
            PHASE_VARS
#define G3_CONV() do { int base = 0; \
                if (l < 3) { if (!odd) base = conv_job(lds, base, IN[I_ODWIN] + (size_t)j * 1024 * 4096, 4096, 1024, 4096, IN[I_MIXG] + (l + 1) * 1024, WIN, 1024, 0, false); \
                             else base = conv_job(lds, base, IN[I_EVWIN] + (size_t)(j + 1) * 1024 * 1536, 1536, 1024, 1536, IN[I_MIXG] + (l + 1) * 1024, WIN, 1024, 0, true); } } while (0)
            if (rep == 0 && (bid & 1) == 0) G3_CONV();
            RowMlpUp R{MB, ssq_mlp};
            if (sb < 4096 / 64) skinny_unit<decltype(R), 1024>(lds, HB + (size_t)MX * D, W1, sb >> 2, sb & 3, R);
            pg8::Gemm g{HB, W1, MX, 4096, 1024}; pg8::StaticOrder S; S.init(MX, 4096, G, bid); EpiAdapt<RowMlpUp> E{R};
            pg8::gemm_phase<EpiAdapt<RowMlpUp>, pg8::StaticOrder, true, true>(lds, g, S, E);
            if (rep == 0 && (bid & 1) != 0) G3_CONV();
#undef G3_CONV
            if (rep < PROBE_MLP) GRID_BAR();
        }
        GRID_BAR();
        for (int rep = 0; rep < 1 + PROBE_MLP; ++rep) {
            PHASE_VARS
            const float gain = (rep < PROBE_MLP) ? (((size_t)p.ws & 1) ? 1.0f : 0.0f) : 1.0f;
            RowRes R{HB, ssq_next, nullptr, gain};
            if (sb < 1024 / 64) skinny_unit<decltype(R), 4096>(lds, MB + (size_t)MX * DFF, W2, sb >> 2, sb & 3, R);
            pg8::Gemm g{MB, W2, MX, 1024, 4096}; pg8::StaticOrder S; S.init(MX, 1024, G, bid); EpiAdapt<RowRes> E{R};
            pg8::gemm_phase<EpiAdapt<RowRes>, pg8::StaticOrder, true, true>(lds, g, S, E);
            if (rep < PROBE_MLP) GRID_BAR();
        }
        GRID_BAR();
    }
    {
        const int l = 0; PHASE_VARS
        const float* fg = IN[I_FING];
        for (int r = gw; r < MX; r += NGW) {
            const float part = (lane < 16) ? SSQ[(size_t)lane * MR + r] : 0.f;
            float s4 = part; s4 += __shfl_xor(s4, 1); s4 += __shfl_xor(s4, 2);
            s4 += __shfl_xor(s4, 4); s4 += __shfl_xor(s4, 8);
            const float tot = __shfl(s4, 0);
            const float rinv = rsqrtf(tot * (1.0f / D) + EPS);
#pragma unroll
            for (int i = 0; i < 4; ++i) { const int c = lane * 4 + 256 * i; const u32x2 hw = *(const u32x2*)(HB + (size_t)r * D + c); f32x4 v = (f32x4){bflo(hw.x), bfhi(hw.x), bflo(hw.y), bfhi(hw.y)}; v = v * rinv * *(const f32x4*)(fg + c); __builtin_nontemporal_store(v, (f32x4*)(((float*)IN[20]) + (size_t)r * D + c)); }
        }
    }
}

extern "C" void kernel_launch(void* const* d_in, const int* in_sizes, int n_in, void* d_out, int out_size, void* d_ws, size_t ws_size, hipStream_t stream) {
    static int grid = 0;
    if (grid == 0) {
        int dev = 0, cus = 0, per_cu = 0;
        if (n_in != 20 || ws_size < WS_END) { fprintf(stderr, "kernel_launch: unexpected n_in %d / ws_size %zu (need %zu)\n", n_in, ws_size, (size_t)WS_END); grid = -1; return; }
        (void)hipGetDevice(&dev);
        (void)hipDeviceGetAttribute(&cus, hipDeviceAttributeMultiprocessorCount, dev);
        if (hipFuncSetAttribute((const void*)fwd, hipFuncAttributeMaxDynamicSharedMemorySize, LDS_BYTES) != hipSuccess) { fprintf(stderr, "kernel_launch: hipFuncSetAttribute failed\n"); grid = -1; return; }
        if (hipOccupancyMaxActiveBlocksPerMultiprocessor(&per_cu, (const void*)fwd, 512, LDS_BYTES) != hipSuccess || per_cu < 1) { fprintf(stderr, "kernel_launch: occupancy query says %d\n", per_cu); per_cu = 1; }
        (void)hipGetLastError();
        grid = cus > 0 ? cus : 256;
    }
    if (grid < 0) return;
    Params p{};
    for (int i = 0; i < 20; ++i) p.in[i] = (const float*)d_in[i];
    p.out = (float*)d_out; p.ws = (unsigned char*)d_ws;
    if (hipMemsetAsync((char*)d_ws + WS_MISC + MISC_BAR, 0, XCD_BAR_WORDS * 4, stream) != hipSuccess) { fprintf(stderr, "kernel_launch: memset of the barrier words failed\n"); return; }
    void* args[] = {&p};
    hipError_t e = hipLaunchCooperativeKernel((const void*)fwd, dim3(grid), dim3(512), args, LDS_BYTES, stream);
    if (e != hipSuccess) fprintf(stderr, "kernel_launch: cooperative launch failed: %s (grid %d)\n", hipGetErrorString(e), grid);
}
```

```cpp
#include <hip/hip_runtime.h>
#include <hip/hip_cooperative_groups.h>
#include <cstdio>
#include <cstdint>
namespace cg = cooperative_groups;

#define LAS __attribute__((address_space(3)))
typedef unsigned short bf16_t;
typedef short bf16x8 __attribute__((ext_vector_type(8)));
typedef float f32x4 __attribute__((ext_vector_type(4)));
typedef float f32x2 __attribute__((ext_vector_type(2)));
typedef unsigned u32x4 __attribute__((ext_vector_type(4)));
typedef unsigned u32x2 __attribute__((ext_vector_type(2)));

constexpr int D = 1024, SEQ = 4096, NMETA = 16, MX = 16384, MR = 16400, DFF = 4096;
constexpr float EPS = 1e-6f;
constexpr int LDS_BYTES = 163840;

constexpr size_t MiB = 1u << 20;
constexpr size_t WS_WIN = 0, WS_WOUT = 8 * MiB, WS_W1 = 10 * MiB, WS_W2 = 18 * MiB, WS_WTMP = 26 * MiB  , WS_SSQ = 28 * MiB  , WS_MISC = 30 * MiB;
constexpr size_t MISC_LB = 0;
constexpr size_t MISC_BIASC = MISC_LB + 2 * 1024 * 4;
constexpr size_t MISC_BIASP = MISC_BIASC + 1024 * 4;
constexpr size_t MISC_HMETA = MISC_BIASP + 4 * 1024 * 4;
constexpr size_t MISC_BAR = MISC_HMETA + 16 * 1024 * 4;
constexpr size_t MISC_INPTR = MISC_BAR + 3456 * 4;
static_assert(MISC_INPTR + 32 * 8 <= MiB && 16 * (size_t)MR * 4 <= 2 * MiB, "misc");
constexpr size_t RB16 = (size_t)MR * 1024 * 2, RB32 = (size_t)MR * 1024 * 4;
constexpr size_t WS_HB = 31 * MiB;
constexpr int NCH = 2056;
constexpr size_t WS_UT = WS_HB + RB16;
constexpr size_t WS_DL = WS_WTMP;
constexpr size_t WS_Q = WS_UT + (size_t)NCH * 32768, WS_V = WS_Q + RB16, WS_SG = WS_V + RB16, WS_LOGF = WS_SG + RB16;
constexpr size_t WS_Y = WS_LOGF;
constexpr size_t WS_AR = WS_HB + RB16;
constexpr size_t WS_A = WS_AR, WS_PIN = WS_A + RB16 / 2, WS_CAT = WS_PIN + RB16 / 2;
constexpr size_t WS_M = WS_AR;
constexpr size_t WS_END = WS_LOGF + RB16;
static_assert(WS_END <= 256 * MiB && WS_M + 4 * RB16 <= 256 * MiB && (size_t)NCH * 512 <= 2 * MiB, "ws map");

typedef __bf16 bf16x2_t __attribute__((ext_vector_type(2)));
__device__ __forceinline__ unsigned cvt_pk_bf16(float lo, float hi) { const f32x2 v = {lo, hi}; const bf16x2_t r = __builtin_convertvector(v, bf16x2_t); return __builtin_bit_cast(unsigned, r); }
__device__ __forceinline__ float bf2f(unsigned short b) { return __uint_as_float(((unsigned)b) << 16); }
__device__ __forceinline__ float bflo(unsigned w) { return __uint_as_float(w << 16); }
__device__ __forceinline__ float bfhi(unsigned w) { return __uint_as_float(w & 0xffff0000u); }
__device__ __forceinline__ float wave_sum(float v) {
#pragma unroll
    for (int o = 32; o >= 1; o >>= 1) v += __shfl_xor(v, o);
    return v;
}
__device__ __forceinline__ float sigm(float x) { return 1.0f / (1.0f + __expf(-x)); }
__device__ __forceinline__ f32x4 sigm4(f32x4 x) { return (f32x4){sigm(x[0]), sigm(x[1]), sigm(x[2]), sigm(x[3])}; }
__device__ __forceinline__ bf16_t f2bf(float x) { return (bf16_t)(cvt_pk_bf16(x, 0.f) & 0xffffu); }
__device__ __forceinline__ u32x4 pack8(f32x4 a, f32x4 b) { u32x4 w; w.x = cvt_pk_bf16(a[0], a[1]); w.y = cvt_pk_bf16(a[2], a[3]); w.z = cvt_pk_bf16(b[0], b[1]); w.w = cvt_pk_bf16(b[2], b[3]); return w; }

__device__ __forceinline__ bf16x8 mk8(f32x4 a, f32x4 b) { const u32x4 w = pack8(a, b); return __builtin_bit_cast(bf16x8, w); }
__device__ __forceinline__ f32x4 exp4(f32x4 x) { return (f32x4){__expf(x[0]), __expf(x[1]), __expf(x[2]), __expf(x[3])}; }

namespace pg8 {
#define PG8_LAS __attribute__((address_space(3)))
constexpr int BM = 256, BK = 64, HALF = 128, HTB = HALF * BK * 2, STAGE_BYTES = 8 * HTB, NXCD = 8, WGM = 8;
__host__ __device__ __forceinline__ int lds_byte(int r, int c) { const int st = (r >> 4) * 2 + (c >> 5), rr = r & 15, cc = c & 31, ob = rr * 64 + cc * 2; return st * 1024 + (ob ^ (((ob >> 9) & 1) << 5)); }
__host__ __device__ __forceinline__ void stage_rc(int b, int& R, int& C) { const int st = b / 1024, sb = b % 1024, swz = sb ^ (((sb >> 9) & 1) << 5); R = (st >> 1) * 16 + swz / 64; C = (st & 1) * 32 + (swz % 64) / 2; }
__host__ __device__ __forceinline__ int perm32(int rho) { const int n = rho >> 4, i = rho & 15; return 8 * (i >> 2) + 4 * n + (i & 3); }
struct Unit { int pm, pn; };
struct Gemm { const bf16_t* A; const bf16_t* Bt; int M, N, K; };
struct StaticOrder {
    int nM, nN, nwg, G, c;
    __host__ __device__ void init(int M, int N, int G_, int c_) { nM = M / BM; nN = N / BM; nwg = nM * nN; G = G_; c = c_; }
    __host__ __device__ bool next(int i, Unit& u) const {
        const long L = (long)i * G + c; if (L >= nwg) return false;
        int wgid = (int)L; { const int q = nwg / NXCD, r = nwg % NXCD, xcd = wgid % NXCD, off = wgid / NXCD; wgid = (xcd < r ? xcd * (q + 1) : r * (q + 1) + (xcd - r) * q) + off; }
        const int nig = WGM * nN, gid = wgid / nig, fm = gid * WGM, gsz = (nM - fm) < WGM ? (nM - fm) : WGM;
        u.pm = fm + ((wgid % nig) % gsz); u.pn = (wgid % nig) / gsz; return true;
    }
    __device__ __forceinline__ void a_ready(const Unit&) const {}
    __device__ __forceinline__ void done(const Unit&) const {}
};

template <class Epi, class Sched, bool ALIGN_EPI = false, bool SP2 = false>
__device__ __forceinline__ void gemm_phase(PG8_LAS unsigned char* lds, const Gemm g, const Sched& S, const Epi& E) {
    int tid = threadIdx.x; asm volatile("" : "+v"(tid));
    const int wid = __builtin_amdgcn_readfirstlane(tid >> 6), lane = tid & 63, wr = wid >> 2, wc = wid & 3, fr = lane & 15, fq = lane >> 4;
    const int K = g.K, nt = K / BK;
    unsigned voffA[2], voffB[2];
#pragma unroll
    for (int i = 0; i < 2; ++i) { int R, C; stage_rc(tid * 16 + i * 8192, R, C); const int Rb = Epi::PERM ? ((R & ~31) + perm32(R & 31)) : R;
        voffA[i] = (unsigned)(R * K + C) * 2u; voffB[i] = (unsigned)(Rb * K + C) * 2u; }
    const size_t kstep = (size_t)(BK * 2);
    const size_t hstep = (size_t)HALF * K * 2;
    const size_t tstep = 2 * hstep;
    const unsigned ldsw = (unsigned)wid * 1024u;
    const int aoff = lds_byte(wr * 64 + fr, fq * 8), boff = lds_byte(wc * 32 + fr, fq * 8);
#define PG8_SA(b, h) (((b) * 2 + (h)) * HTB)
#define PG8_SB(b, h) ((4 + (b) * 2 + (h)) * HTB)
#define PG8_STAGE(bufoff, gbase, voff) do { _Pragma("unroll") for (int _i = 0; _i < 2; ++_i) \
        __builtin_amdgcn_global_load_lds((const unsigned*)((const char*)(gbase) + (voff)[_i]), (PG8_LAS unsigned*)(lds + (bufoff) + ldsw + _i * 8192), 16, 0, 0); } while (0)
#define PG8_LDA(dst, b, h) do { _Pragma("unroll") for (int m = 0; m < 4; ++m) _Pragma("unroll") for (int k = 0; k < 2; ++k) dst[m][k] = *(const PG8_LAS bf16x8*)(lds + PG8_SA(b, h) + aoff + m * 2048 + k * 1024); } while (0)
#define PG8_LDB(dst, b, h) do { _Pragma("unroll") for (int n = 0; n < 2; ++n) _Pragma("unroll") for (int k = 0; k < 2; ++k) dst[n][k] = *(const PG8_LAS bf16x8*)(lds + PG8_SB(b, h) + boff + n * 2048 + k * 1024); } while (0)
#define PG8_MMA(ai, bj, At, Bt) do { __builtin_amdgcn_s_setprio(1); _Pragma("unroll") for (int m = 0; m < 4; ++m) _Pragma("unroll") for (int n = 0; n < 2; ++n) _Pragma("unroll") for (int k = 0; k < 2; ++k) \
        acc[ai][bj][m][n] = __builtin_amdgcn_mfma_f32_16x16x32_bf16(Bt[n][k], At[m][k], acc[ai][bj][m][n], 0, 0, 0); __builtin_amdgcn_s_setprio(0); } while (0)
#define PG8_WAIT_V(n) asm volatile("s_waitcnt vmcnt(" #n ")" ::: "memory")
#define PG8_WAIT_L(n) asm volatile("s_waitcnt lgkmcnt(" #n ")" ::: "memory")
#define PG8_BAR __builtin_amdgcn_s_barrier()
#define PG8_SCHED __builtin_amdgcn_sched_barrier(0)
    Unit cur, nxt; int ui = 0;
    if (!S.next(0, cur)) return;
    f32x4 acc[2][2][4][2];
#pragma unroll
    for (int a = 0; a < 2; ++a)
#pragma unroll
        for (int b = 0; b < 2; ++b)
#pragma unroll
            for (int m = 0; m < 4; ++m)
#pragma unroll
                for (int n = 0; n < 2; ++n) acc[a][b][m][n] = (f32x4){0.f, 0.f, 0.f, 0.f};
    bf16x8 At[4][2], B0[2][2], B1[2][2];
    const char* cA = (const char*)g.A + (size_t)cur.pm * tstep; const char* cB = (const char*)g.Bt + (size_t)cur.pn * tstep;
    S.a_ready(cur);
    if constexpr (SP2) {
        PG8_STAGE(PG8_SB(0, 0), cB, voffB); PG8_STAGE(PG8_SB(0, 1), cB + hstep, voffB); PG8_STAGE(PG8_SA(0, 0), cA, voffA); PG8_STAGE(PG8_SA(0, 1), cA + hstep, voffA);
        if (wr == 1) PG8_BAR;
        PG8_WAIT_V(2); PG8_BAR;
        PG8_STAGE(PG8_SB(1, 0), cB + kstep, voffB); PG8_STAGE(PG8_SA(1, 0), cA + kstep, voffA); PG8_STAGE(PG8_SB(1, 1), cB + hstep + kstep, voffB);
        PG8_WAIT_V(6); PG8_BAR;
    } else {
        PG8_STAGE(PG8_SB(0, 0), cB, voffB); PG8_STAGE(PG8_SA(0, 0), cA, voffA); PG8_STAGE(PG8_SB(0, 1), cB + hstep, voffB); PG8_STAGE(PG8_SA(0, 1), cA + hstep, voffA);
        if (wr == 1) PG8_BAR;
        PG8_WAIT_V(4); PG8_BAR;
        PG8_STAGE(PG8_SB(1, 0), cB + kstep, voffB); PG8_STAGE(PG8_SA(1, 0), cA + kstep, voffA); PG8_STAGE(PG8_SB(1, 1), cB + hstep + kstep, voffB);
        PG8_WAIT_V(6); PG8_BAR;
    }
    for (;;) {
        const bool has_next = S.next(ui + 1, nxt);
        const char* nA = has_next ? (const char*)g.A + (size_t)nxt.pm * tstep : cA; const char* nB = has_next ? (const char*)g.Bt + (size_t)nxt.pn * tstep : cB;
        for (int t = 0; t < nt; t += 2) {
            const bool last = (t == nt - 2);
            const char* a1 = cA + (size_t)(t + 1) * kstep;
            const char* a2 = last ? nA : cA + (size_t)(t + 2) * kstep; const char* b2 = last ? nB : cB + (size_t)(t + 2) * kstep;
            const char* a3 = a2 + kstep; const char* b3 = b2 + kstep;
            if (last && has_next) S.a_ready(nxt);
            if constexpr (SP2) {
            PG8_LDB(B0, 0, 0); PG8_LDB(B1, 0, 1); PG8_SCHED; PG8_LDA(At, 0, 0); PG8_STAGE(PG8_SA(1, 1), a1 + hstep, voffA);
            PG8_WAIT_V(8); PG8_WAIT_L(0); PG8_BAR; PG8_MMA(0, 0, At, B0); PG8_MMA(0, 1, At, B1); PG8_BAR; PG8_SCHED;
            PG8_LDA(At, 0, 1); PG8_STAGE(PG8_SB(0, 0), b2, voffB); PG8_STAGE(PG8_SB(0, 1), b2 + hstep, voffB); PG8_STAGE(PG8_SA(0, 0), a2, voffA);
            PG8_WAIT_V(8); PG8_WAIT_L(0); PG8_BAR; PG8_MMA(1, 0, At, B0); PG8_MMA(1, 1, At, B1); PG8_BAR; PG8_SCHED;
            PG8_LDB(B0, 1, 0); PG8_LDB(B1, 1, 1); PG8_SCHED; PG8_LDA(At, 1, 0); PG8_STAGE(PG8_SA(0, 1), a2 + hstep, voffA);
            PG8_WAIT_V(8); PG8_WAIT_L(0); PG8_BAR; PG8_MMA(0, 0, At, B0); PG8_MMA(0, 1, At, B1); PG8_BAR; PG8_SCHED;
            PG8_LDA(At, 1, 1); PG8_STAGE(PG8_SB(1, 0), b3, voffB); PG8_STAGE(PG8_SB(1, 1), b3 + hstep, voffB); PG8_STAGE(PG8_SA(1, 0), a3, voffA);
            PG8_WAIT_V(8); PG8_WAIT_L(0); PG8_BAR; PG8_MMA(1, 0, At, B0); PG8_MMA(1, 1, At, B1); PG8_BAR; PG8_SCHED;
            } else {
            PG8_LDB(B0, 0, 0); PG8_SCHED; PG8_LDA(At, 0, 0); PG8_STAGE(PG8_SA(1, 1), a1 + hstep, voffA);
            PG8_WAIT_L(8); PG8_BAR; PG8_WAIT_L(0); PG8_MMA(0, 0, At, B0); PG8_BAR; PG8_SCHED;
            PG8_LDB(B1, 0, 1); PG8_STAGE(PG8_SB(0, 0), b2, voffB);
            PG8_BAR; PG8_WAIT_L(0); PG8_MMA(0, 1, At, B1); PG8_BAR;
            PG8_LDA(At, 0, 1); PG8_STAGE(PG8_SA(0, 0), a2, voffA);
            PG8_BAR; PG8_WAIT_L(0); PG8_MMA(1, 0, At, B0); PG8_BAR; PG8_SCHED;
            PG8_STAGE(PG8_SB(0, 1), b2 + hstep, voffB);
            PG8_WAIT_V(6); PG8_BAR; PG8_MMA(1, 1, At, B1); PG8_BAR;
            PG8_LDB(B0, 1, 0); PG8_SCHED; PG8_LDA(At, 1, 0); PG8_STAGE(PG8_SA(0, 1), a2 + hstep, voffA);
            PG8_WAIT_L(8); PG8_BAR; PG8_WAIT_L(0); PG8_MMA(0, 0, At, B0); PG8_BAR; PG8_SCHED;
            PG8_LDB(B1, 1, 1); PG8_STAGE(PG8_SB(1, 0), b3, voffB);
            PG8_BAR; PG8_WAIT_L(0); PG8_MMA(0, 1, At, B1); PG8_BAR;
            PG8_LDA(At, 1, 1); PG8_STAGE(PG8_SA(1, 0), a3, voffA);
            PG8_BAR; PG8_WAIT_L(0); PG8_MMA(1, 0, At, B0); PG8_BAR; PG8_SCHED;
            PG8_STAGE(PG8_SB(1, 1), b3 + hstep, voffB);
            PG8_WAIT_V(6); PG8_BAR; PG8_MMA(1, 1, At, B1); PG8_BAR;
            }
        }
        if constexpr (ALIGN_EPI) { if (wr == 0) PG8_BAR; }
        E(acc, cur, wr, wc, fr, fq);
        if (!has_next) break;
#pragma unroll
        for (int a = 0; a < 2; ++a)
#pragma unroll
            for (int b = 0; b < 2; ++b)
#pragma unroll
                for (int m = 0; m < 4; ++m)
#pragma unroll
                    for (int n = 0; n < 2; ++n) acc[a][b][m][n] = (f32x4){0.f, 0.f, 0.f, 0.f};
        cur = nxt; cA = nA; cB = nB; ++ui;
        if constexpr (ALIGN_EPI) { if (wr == 1) PG8_BAR; }
    }
    PG8_WAIT_V(0);
    if constexpr (!ALIGN_EPI) { if (wr == 0) PG8_BAR; }
    PG8_BAR;
#undef PG8_SA
#undef PG8_SB
#undef PG8_STAGE
#undef PG8_LDA
#undef PG8_LDB
#undef PG8_MMA
#undef PG8_WAIT_V
#undef PG8_WAIT_L
#undef PG8_BAR
#undef PG8_SCHED
}
}

__device__ __forceinline__ float row_rinv(const float* ssq, int r, int fq) {
    const float* q = ssq + (size_t)(4 * fq) * MR + r;
    float s = (q[0] + q[MR]) + (q[2 * MR] + q[3 * MR]);
    s += __shfl_xor(s, 16); s += __shfl_xor(s, 32);
    return rsqrtf(s * (1.0f / D) + EPS);
}
struct RowEvenIn {
    bf16_t* Abuf; bf16_t* Pin; const float* ssq;
    __device__ __forceinline__ float prep(int r, int fq) const { return row_rinv(ssq, r, fq); }
    __device__ __forceinline__ void row(int r, int pn, int wc, int fq, f32x4 v00, f32x4 v01, f32x4 v10, f32x4 v11, float rinv) const {
        if (pn < 4) {
            const int col = 128 * pn + 32 * wc + 8 * fq;
            const f32x4 a0 = (v00 * rinv) * sigm4(v10 * rinv), a1 = (v01 * rinv) * sigm4(v11 * rinv);
            *(u32x4*)(Abuf + (size_t)r * 512 + col) = pack8(a0, a1);
        } else {
            const int col = (pn - 4) * 256 + 32 * wc + 8 * fq;
            *(u32x4*)(Pin + (size_t)r * 512 + col) = pack8(v00 * rinv, v01 * rinv);
            *(u32x4*)(Pin + (size_t)r * 512 + col + 128) = pack8(v10 * rinv, v11 * rinv);
        }
    }
};
struct RowOddIn {
    bf16_t* Q; bf16_t* LOGF; bf16_t* V; bf16_t* SG; const float* ssq; const float* lb;
    __device__ __forceinline__ float prep(int r, int fq) const { return row_rinv(ssq, r, fq); }
    __device__ __forceinline__ void row(int r, int pn, int wc, int fq, f32x4 v00, f32x4 v01, f32x4 v10, f32x4 v11, float rinv) const {
        const int type = pn >> 2, col = (pn & 3) * 256 + 32 * wc + 8 * fq;
        const size_t o = (size_t)r * 1024 + col;
        v00 = v00 * rinv; v01 = v01 * rinv; v10 = v10 * rinv; v11 = v11 * rinv;
        if (type == 0) {
            *(u32x4*)(Q + o) = pack8(v00 * sigm4(v00), v01 * sigm4(v01)); *(u32x4*)(Q + o + 128) = pack8(v10 * sigm4(v10), v11 * sigm4(v11));
        } else if (type == 1) {
            const f32x4 l00 = *(const f32x4*)(lb + col), l01 = *(const f32x4*)(lb + col + 4), l10 = *(const f32x4*)(lb + col + 128), l11 = *(const f32x4*)(lb + col + 132);
            f32x4 f00 = l00 + (1.0f - l00) * sigm4(v00), f01 = l01 + (1.0f - l01) * sigm4(v01), f10 = l10 + (1.0f - l10) * sigm4(v10), f11 = l11 + (1.0f - l11) * sigm4(v11);
#pragma unroll
            for (int j = 0; j < 4; ++j) { f00[j] = __logf(f00[j]); f01[j] = __logf(f01[j]); f10[j] = __logf(f10[j]); f11[j] = __logf(f11[j]); }
            *(u32x4*)(LOGF + o) = pack8(f00, f01); *(u32x4*)(LOGF + o + 128) = pack8(f10, f11);
        } else if (type == 2) {
            *(u32x4*)(V + o) = pack8(v00, v01); *(u32x4*)(V + o + 128) = pack8(v10, v11);
        } else {
            *(u32x4*)(SG + o) = pack8(v00 * sigm4(v00), v01 * sigm4(v01)); *(u32x4*)(SG + o + 128) = pack8(v10 * sigm4(v10), v11 * sigm4(v11));
        }
    }
};
struct RowRes {
    bf16_t* hb; float* ssq; const float* bias; float gain;
    __device__ __forceinline__ float prep(int, int) const { return 0.f; }
    __device__ __forceinline__ void row(int r, int pn, int wc, int fq, f32x4 v00, f32x4 v01, f32x4 v10, f32x4 v11, float) const {
        const int col = 256 * pn + 32 * wc + 8 * fq;
        bf16_t* hp = hb + (size_t)r * D + col;
        const u32x4 h0 = *(const u32x4*)hp, h1 = *(const u32x4*)(hp + 128);
        if (bias) { v00 += *(const f32x4*)(bias + col); v01 += *(const f32x4*)(bias + col + 4); v10 += *(const f32x4*)(bias + col + 128); v11 += *(const f32x4*)(bias + col + 132); }
        v00 = v00 * gain + (f32x4){bflo(h0.x), bfhi(h0.x), bflo(h0.y), bfhi(h0.y)}; v01 = v01 * gain + (f32x4){bflo(h0.z), bfhi(h0.z), bflo(h0.w), bfhi(h0.w)};
        v10 = v10 * gain + (f32x4){bflo(h1.x), bfhi(h1.x), bflo(h1.y), bfhi(h1.y)}; v11 = v11 * gain + (f32x4){bflo(h1.z), bfhi(h1.z), bflo(h1.w), bfhi(h1.w)};
        *(u32x4*)hp = pack8(v00, v01); *(u32x4*)(hp + 128) = pack8(v10, v11);
        const f32x4 q = v00 * v00 + v01 * v01 + v10 * v10 + v11 * v11;
        float s = (q[0] + q[1]) + (q[2] + q[3]);
        s += __shfl_xor(s, 16); s += __shfl_xor(s, 32);
        if (fq == 0) ssq[(size_t)(pn * 4 + wc) * MR + r] = s;
    }
};
struct RowMlpUp {
    bf16_t* Mb; const float* ssq;
    __device__ __forceinline__ float prep(int r, int fq) const { return row_rinv(ssq, r, fq); }
    __device__ __forceinline__ void row(int r, int pn, int wc, int fq, f32x4 v00, f32x4 v01, f32x4 v10, f32x4 v11, float rinv) const {
        const int col = 256 * pn + 32 * wc + 8 * fq;
        const f32x4 z = (f32x4){0.f, 0.f, 0.f, 0.f};
        v00 = __builtin_elementwise_max(v00 * rinv, z); v01 = __builtin_elementwise_max(v01 * rinv, z); v10 = __builtin_elementwise_max(v10 * rinv, z); v11 = __builtin_elementwise_max(v11 * rinv, z);
        __builtin_nontemporal_store(pack8(v00 * v00, v01 * v01), (u32x4*)(Mb + (size_t)r * DFF + col)); __builtin_nontemporal_store(pack8(v10 * v10, v11 * v11), (u32x4*)(Mb + (size_t)r * DFF + col + 128));
    }
};
template <class Row> struct EpiAdapt {
    static constexpr bool PERM = true, AFTER_DRAIN = false;
    Row R;
    __device__ __forceinline__ void operator()(const f32x4 (&acc)[2][2][4][2], const pg8::Unit& u, int wr, int wc, int fr, int fq) const {
        asm volatile("" ::: "memory");
#pragma unroll
        for (int ai = 0; ai < 2; ++ai)
#pragma unroll
            for (int m = 0; m < 4; ++m) { const int r = u.pm * 256 + ai * 128 + wr * 64 + m * 16 + fr; R.row(r, u.pn, wc, fq, acc[ai][0][m][0], acc[ai][0][m][1], acc[ai][1][m][0], acc[ai][1][m][1], R.prep(r, fq)); }
    }
};

template <class Row, int K>
__device__ __forceinline__ void skinny_unit(LAS unsigned char* lds, const bf16_t* A16, const bf16_t* Bt, int pn, int wc, const Row& R) {
    int tid = threadIdx.x; asm volatile("" : "+v"(tid));
    const int wid = __builtin_amdgcn_readfirstlane(tid >> 6), lane = tid & 63, fr = lane & 15, fq = lane >> 4;
    constexpr int KS = K / 8, NG = KS / 128;
    float rinv = 0.f; if (wid == 0) rinv = R.prep(MX + fr, fq);
    f32x4 acc[4];
#pragma unroll
    for (int t = 0; t < 4; ++t) acc[t] = (f32x4){0.f, 0.f, 0.f, 0.f};
    const bf16_t* ap = A16 + (size_t)fr * K + wid * KS + fq * 8;
    const bf16_t* bp = Bt + (size_t)(256 * pn + 32 * wc + 8 * (fr >> 2) + (fr & 3)) * K + wid * KS + fq * 8;
    bf16x8 af[1][4], bf[1][4][4];
#define SK_LOAD(buf, g) do { _Pragma("unroll") for (int st = 0; st < 4; ++st) { af[buf][st] = *(const bf16x8*)(ap + (g) * 128 + st * 32); \
        _Pragma("unroll") for (int t = 0; t < 4; ++t) bf[buf][st][t] = *(const bf16x8*)(bp + (size_t)(128 * (t >> 1) + 4 * (t & 1)) * K + (g) * 128 + st * 32); } } while (0)
    SK_LOAD(0, 0);
#pragma unroll
    for (int g = 0; g < NG; ++g) {
        if (g > 0) SK_LOAD(0, g);
#pragma unroll
        for (int st = 0; st < 4; ++st)
#pragma unroll
            for (int t = 0; t < 4; ++t) acc[t] = __builtin_amdgcn_mfma_f32_16x16x32_bf16(bf[0][st][t], af[0][st], acc[t], 0, 0, 0);
    }
#undef SK_LOAD
    LAS float* red = (LAS float*)lds;
#pragma unroll
    for (int t = 0; t < 4; ++t)
#pragma unroll
        for (int j = 0; j < 4; ++j) red[(wid * 16 + t * 4 + j) * 64 + lane] = acc[t][j];
    __syncthreads();
    if (wid == 0) {
        f32x4 v[4];
#pragma unroll
        for (int t = 0; t < 4; ++t)
#pragma unroll
            for (int j = 0; j < 4; ++j) { float sm = 0.f;
#pragma unroll
                for (int w = 0; w < 8; ++w) sm += red[(w * 16 + t * 4 + j) * 64 + lane];
                v[t][j] = sm; }
        R.row(MX + fr, pn, wc, fq, v[0], v[1], v[2], v[3], rinv);
    }
    __syncthreads();
}

__device__ __forceinline__ int glu_rowmap(int n0) { if (n0 < 512) return 256 * (n0 >> 7) + (n0 & 127); if (n0 < 1024) { const int n1 = n0 - 512; return 256 * (n1 >> 7) + 128 + (n1 & 127); } return n0; }
__device__ __forceinline__ int conv_job(LAS unsigned char* lds, int base, const float* src, int ldn, int K, int N, const float* gain, bf16_t* dst, int dst_ld, int koff, bool glu, int G = gridDim.x, int blk = blockIdx.x) {
    int tid = threadIdx.x; asm volatile("" : "+v"(tid));
    const int nT = N >> 6, nitems = (K >> 6) * nT;
    int first = (blk - base) % G; if (first < 0) first += G;
    const int kk0 = tid >> 4, n4 = (tid & 15) * 4;
    f32x4 x0 = (f32x4){0.f, 0.f, 0.f, 0.f}, x1 = x0, y0 = x0, y1 = x0;
#define CJ_LOAD(it_, x0, x1) do { const int kt_ = (it_) / nT, nt_ = (it_) - kt_ * nT; const float* s_ = src + (size_t)(kt_ * 64 + kk0) * ldn + nt_ * 64 + n4; \
        x0 = *(const f32x4*)s_; x1 = *(const f32x4*)(s_ + (size_t)32 * ldn); \
        if (gain) { x0 = x0 * gain[kt_ * 64 + kk0]; x1 = x1 * gain[kt_ * 64 + kk0 + 32]; } } while (0)
    if (first < nitems) CJ_LOAD(first, x0, x1);
    if (first + G < nitems) CJ_LOAD(first + G, y0, y1);
    int buf = 0;
    for (int it = first; it < nitems; it += G) {
        LAS float* tile = (LAS float*)lds + buf * (64 * 65);
        const int kt = it / nT, ntile = it - kt * nT, k0 = kt * 64, n0 = ntile * 64, drow0 = glu ? glu_rowmap(n0) : n0;
        tile[kk0 * 65 + n4 + 0] = x0[0]; tile[kk0 * 65 + n4 + 1] = x0[1]; tile[kk0 * 65 + n4 + 2] = x0[2]; tile[kk0 * 65 + n4 + 3] = x0[3];
        tile[(kk0 + 32) * 65 + n4 + 0] = x1[0]; tile[(kk0 + 32) * 65 + n4 + 1] = x1[1]; tile[(kk0 + 32) * 65 + n4 + 2] = x1[2]; tile[(kk0 + 32) * 65 + n4 + 3] = x1[3];
        x0 = y0; x1 = y1;
        if (it + 2 * G < nitems) CJ_LOAD(it + 2 * G, y0, y1);
        __syncthreads();
        { const int n = tid >> 3, kc = (tid & 7) * 8; u32x4 w;
          w.x = cvt_pk_bf16(tile[(kc + 0) * 65 + n], tile[(kc + 1) * 65 + n]); w.y = cvt_pk_bf16(tile[(kc + 2) * 65 + n], tile[(kc + 3) * 65 + n]);
          w.z = cvt_pk_bf16(tile[(kc + 4) * 65 + n], tile[(kc + 5) * 65 + n]); w.w = cvt_pk_bf16(tile[(kc + 6) * 65 + n], tile[(kc + 7) * 65 + n]);
          *(u32x4*)(dst + (size_t)(drow0 + n) * dst_ld + koff + k0 + kc) = w; }
        buf ^= 1;
    }
#undef CJ_LOAD
    __syncthreads();
    return base + nitems;
}

struct Params { const float* in[20]; float* out; unsigned char* ws; };
enum { I_X = 0, I_META, I_MIXG, I_MLPG, I_FING, I_EVWIN, I_CONVW, I_CONVB, I_LNG, I_LNB, I_POOLW, I_POOLB, I_POOLS, I_EVWOUT, I_ODWIN, I_GNORM, I_ODWOUT, I_LBP, I_W1, I_W2 };

__device__ __forceinline__ int seqrow(int b, int p) { return p < NMETA ? MX + p : b * SEQ + (p - NMETA); }

#define XB_TMO      128
#define XB_XCNT(j)  (256  + 64 * (j))
#define XB_XSUB(j)  (1280 + 64 * (j))
#define XB_XGEN(j)  (2304 + 64 * (j))
#define XB_TOP      3328
#define XB_TOPGEN   3392
#define XCD_BAR_WORDS 3456
#define XB_SPIN_CAP (1u << 18)

__device__ __forceinline__ unsigned xb_ld(unsigned* p)              { return __hip_atomic_load(p, __ATOMIC_RELAXED, __HIP_MEMORY_SCOPE_AGENT); }
__device__ __forceinline__ unsigned xb_add(unsigned* p, unsigned v) { return __hip_atomic_fetch_add(p, v, __ATOMIC_RELAXED, __HIP_MEMORY_SCOPE_AGENT); }
__device__ __forceinline__ unsigned xb_xcc_id() { return (unsigned)__builtin_amdgcn_s_getreg((3 << 11) | 20) & 0xFu; }
#define XB_SPIN(cond, bar) do { unsigned _sp = 0; while (cond) { __builtin_amdgcn_s_sleep(1); \
    if ((++_sp & 255u) == 0u) { if (xb_ld(&(bar)[XB_TMO])) break; if (_sp > XB_SPIN_CAP) { atomicAdd(&(bar)[XB_TMO], 1u); break; } } } } while (0)

struct XcdBarrier {
    unsigned* bar; unsigned x;
    volatile LAS unsigned* st;
};

__device__ __forceinline__ XcdBarrier xcd_barrier_post(unsigned* bar, volatile LAS unsigned* st) {
    XcdBarrier b; b.bar = bar; b.x = xb_xcc_id(); b.st = st;
    if (threadIdx.x == 0) (void)xb_add(&bar[XB_XCNT(b.x)], 1u);
    return b;
}
__device__ __forceinline__ void xcd_barrier_complete(unsigned* bar, unsigned x, unsigned& nloc, unsigned& nx) {
    const unsigned G = gridDim.x * gridDim.y * gridDim.z;
    unsigned sum, cnt, mine, sp = 0u;
    for (;;) {
        sum = 0u; cnt = 0u; mine = 0u;
#pragma unroll
        for (unsigned j = 0; j < 16; ++j) { const unsigned c = xb_ld(&bar[XB_XCNT(j)]); sum += c; cnt += (c > 0u) ? 1u : 0u; }
        mine = xb_ld(&bar[XB_XCNT(x)]);
        if (sum == G) break;
        __builtin_amdgcn_s_sleep(1);
        if ((++sp & 255u) == 0u) { if (xb_ld(&bar[XB_TMO])) break; if (sp > XB_SPIN_CAP) { atomicAdd(&bar[XB_TMO], 1u); break; } }
    }
    nloc = mine > 0u ? mine : 1u; nx = cnt > 0u ? cnt : 1u;
}

__device__ __forceinline__ void xcd_barrier(const XcdBarrier& b) {
    asm volatile("s_waitcnt vmcnt(0)" ::: "memory");
    __syncthreads();
    if (threadIdx.x == 0) {
        unsigned* bar = b.bar;
        __builtin_amdgcn_s_waitcnt(0);
        unsigned nloc = b.st[0], nx = b.st[1];
        if (nloc == 0u) { xcd_barrier_complete(bar, b.x, nloc, nx); b.st[0] = nloc; b.st[1] = nx; }
        const unsigned old = xb_add(&bar[XB_XSUB(b.x)], 1u);
        const unsigned gen = old / nloc;
        if (old + 1u == (gen + 1u) * nloc) {
            __builtin_amdgcn_fence(__ATOMIC_RELEASE, "agent");
            asm volatile("s_waitcnt vmcnt(0)" ::: "memory");
            const unsigned og = xb_add(&bar[XB_TOP], 1u);
            const unsigned tg = og / nx;
            if (og + 1u == (tg + 1u) * nx) xb_add(&bar[XB_TOPGEN], 1u);
            else XB_SPIN(xb_ld(&bar[XB_TOPGEN]) == tg, bar);
            __builtin_amdgcn_fence(__ATOMIC_ACQUIRE, "agent");
            xb_add(&bar[XB_XGEN(b.x)], 1u);
            asm volatile("s_waitcnt vmcnt(0)" ::: "memory");
        } else {
            XB_SPIN(xb_ld(&bar[XB_XGEN(b.x)]) == gen, bar);
            __builtin_amdgcn_fence(__ATOMIC_ACQUIRE, "agent");
            asm volatile("s_waitcnt vmcnt(0)" ::: "memory");
        }
    }
    __syncthreads();
}

#define PHASE_VARS \
    unsigned char* ws = p.ws; asm volatile("" : "+s"(ws)); \
    int tid = threadIdx.x; asm volatile("" : "+v"(tid)); \
    const int lane = tid & 63, wid = __builtin_amdgcn_readfirstlane(tid >> 6); \
    const float* const* IN = (const float* const*)(ws + WS_MISC + MISC_INPTR); (void)IN; \
    const int gw = bid * 8 + wid, gt = bid * 512 + tid; (void)gw; (void)gt; (void)lane; \
    bf16_t* WIN = (bf16_t*)(ws + WS_WIN); bf16_t* WOUT = (bf16_t*)(ws + WS_WOUT); bf16_t* W1 = (bf16_t*)(ws + WS_W1); bf16_t* W2 = (bf16_t*)(ws + WS_W2); \
    float* WTMP = (float*)(ws + WS_WTMP); \
    float* SSQ = (float*)(ws + WS_SSQ); float* LB = (float*)(ws + WS_MISC + MISC_LB); float* BIASC = (float*)(ws + WS_MISC + MISC_BIASC); float* BIASP = (float*)(ws + WS_MISC + MISC_BIASP); float* HMETA = (float*)(ws + WS_MISC + MISC_HMETA); (void)BIASP; \
    bf16_t* HB = (bf16_t*)(ws + WS_HB); bf16_t* UT = (bf16_t*)(ws + WS_UT); float* DL = (float*)(ws + WS_DL); (void)UT; (void)DL; \
    bf16_t* QB = (bf16_t*)(ws + WS_Q); bf16_t* VB = (bf16_t*)(ws + WS_V); bf16_t* SG = (bf16_t*)(ws + WS_SG); bf16_t* LOGF = (bf16_t*)(ws + WS_LOGF); bf16_t* YB = (bf16_t*)(ws + WS_Y); \
    bf16_t* AB = (bf16_t*)(ws + WS_A); bf16_t* PIN = (bf16_t*)(ws + WS_PIN); bf16_t* CAT = (bf16_t*)(ws + WS_CAT); bf16_t* MB = (bf16_t*)(ws + WS_M); \
    (void)WIN; (void)WOUT; (void)W1; (void)W2; (void)WTMP; (void)SSQ; (void)LB; (void)BIASC; (void)HMETA; (void)HB; (void)QB; (void)VB; (void)SG; (void)LOGF; (void)YB; (void)AB; (void)PIN; (void)CAT; (void)MB; \
    const int j = l >> 1; const bool odd = (l & 1) != 0; const int sb = G - 1 - bid; (void)j; (void)odd; (void)sb; \
    const float* ssq_mix = SSQ; float* ssq_mlp = SSQ; float* ssq_next = SSQ; (void)ssq_mix; (void)ssq_mlp; (void)ssq_next;


#ifndef PROBE_MLP
#define PROBE_MLP 0
#endif
#ifndef PROBE_MIX
#define PROBE_MIX 0
#endif
#define PASSC_ITEMS(wlo_, whi_) do { \
                for (int wi = (wlo_) + gw; wi < (whi_); wi += NGW) { \
                    int it, tp; if (wi < 4096) { it = wi >> 1; tp = wi & 1; } else { it = 2048 + (wi - 4096); tp = 1; } \
                    const int cidx = it >> 3, hc = (it & 7) * 128; const bool meta = (cidx == 256); \
                    const int lr0 = 32 * tp + fr, lr1 = lr0 + 16; \
                    const int gr0 = meta ? (lr0 >= 48 ? MX + lr0 - 48 : -1) : cidx * 64 + lr0, gr1 = meta ? (lr1 >= 48 ? MX + lr1 - 48 : -1) : cidx * 64 + lr1; \
                    f32x4 acc0[8], acc1[8]; \
                    _Pragma("unroll") for (int vb = 0; vb < 8; ++vb) { acc0[vb] = (f32x4){0.f, 0.f, 0.f, 0.f}; acc1[vb] = acc0[vb]; } \
                    if (!meta) { \
                        const bf16_t* sp = UT + (size_t)it * 16384 + (size_t)fr * 128 + 8 * fq; \
                        const bf16_t* qp0 = QB + (size_t)gr0 * 1024 + hc + 8 * fq; const bf16_t* qp1 = QB + (size_t)gr1 * 1024 + hc + 8 * fq; \
                        bf16x8 qf0[4], qf1[4]; \
                        _Pragma("unroll") for (int kk = 0; kk < 4; ++kk) { qf0[kk] = *(const bf16x8*)(qp0 + 32 * kk); qf1[kk] = *(const bf16x8*)(qp1 + 32 * kk); } \
                        _Pragma("unroll") for (int vb = 0; vb < 8; ++vb) { \
                            _Pragma("unroll") for (int kk = 0; kk < 4; ++kk) { const bf16x8 sf = *(const bf16x8*)(sp + vb * 16 * 128 + 32 * kk); \
                                acc0[vb] = __builtin_amdgcn_mfma_f32_16x16x32_bf16(sf, qf0[kk], acc0[vb], 0, 0, 0); acc1[vb] = __builtin_amdgcn_mfma_f32_16x16x32_bf16(sf, qf1[kk], acc1[vb], 0, 0, 0); } \
                            if (vb & 1) asm volatile("" ::: "memory"); } \
                    } \
                    _Pragma("unroll") for (int u = 0; u < 2; ++u) { const int gr = u ? gr1 : gr0; \
                        if (gr >= 0) { \
                            float ss = 0.f; f32x4 o[8]; \
                            _Pragma("unroll") for (int vb = 0; vb < 8; ++vb) { const u32x2 oi = *(const u32x2*)(VB + (size_t)gr * 1024 + hc + 16 * vb + 4 * fq); \
                                o[vb] = (u ? acc1[vb] : acc0[vb]) + (f32x4){bflo(oi.x), bfhi(oi.x), bflo(oi.y), bfhi(oi.y)}; const f32x4 q2 = o[vb] * o[vb]; ss += (q2[0] + q2[1]) + (q2[2] + q2[3]); } \
                            ss += __shfl_xor(ss, 16); ss += __shfl_xor(ss, 32); \
                            const float rn = rsqrtf(ss * (1.0f / 128.0f) + EPS); \
                            _Pragma("unroll") for (int vb = 0; vb < 8; ++vb) { const int col = 16 * vb + 4 * fq; const u32x2 sg = *(const u32x2*)(SG + (size_t)gr * 1024 + hc + col); \
                                const f32x4 y = o[vb] * rn * *(const f32x4*)(gg + col) * (f32x4){bflo(sg.x), bfhi(sg.x), bflo(sg.y), bfhi(sg.y)}; \
                                u32x2 w; w.x = cvt_pk_bf16(y[0], y[1]); w.y = cvt_pk_bf16(y[2], y[3]); *(u32x2*)(YB + (size_t)gr * 1024 + hc + col) = w; } } } \
                } \
} while (0)
__global__ void __launch_bounds__(512, 2) fwd(Params p) {
    extern __shared__ __attribute__((aligned(16))) unsigned char lds_raw[];
    cg::grid_group grid = cg::this_grid();
    LAS unsigned char* lds = (LAS unsigned char*)lds_raw;
    const int bid = blockIdx.x, G = gridDim.x, NGW = G * 8, NGT = G * 512;
    volatile LAS unsigned* bar_st = (volatile LAS unsigned*)(lds + LDS_BYTES - 16);
    if (threadIdx.x < 4) bar_st[threadIdx.x] = 0u;
    if (bid == 0) {
        if (threadIdx.x == 0) { const float** tb = (const float**)(p.ws + WS_MISC + MISC_INPTR);
#pragma unroll
            for (int i = 0; i < 20; ++i) tb[i] = p.in[i];
            tb[20] = p.out; } }
    __syncthreads();
    const XcdBarrier xbar = xcd_barrier_post((unsigned*)(p.ws + WS_MISC + MISC_BAR), bar_st);
#define GRID_BAR() xcd_barrier(xbar)
    {
        const int l = 0; PHASE_VARS
        for (int r = gw; r < MR; r += NGW) {
            const float* src = (r < MX) ? p.in[I_X] + (size_t)r * D : p.in[I_META] + (size_t)(r - MX) * D;
            float s = 0.f;
#pragma unroll
            for (int i = 0; i < 4; ++i) { const int c = lane * 4 + 256 * i; const f32x4 v = __builtin_nontemporal_load((const f32x4*)(src + c));
                u32x2 w; w.x = cvt_pk_bf16(v[0], v[1]); w.y = cvt_pk_bf16(v[2], v[3]); *(u32x2*)(HB + (size_t)r * D + c) = w;
                s += (v[0] * v[0] + v[1] * v[1]) + (v[2] * v[2] + v[3] * v[3]); }
            s = wave_sum(s); if (lane < 16) SSQ[(size_t)lane * MR + r] = (lane == 0) ? s : 0.f;
        }
        if (gt < 1024) {
            const float* lp = p.in[I_LBP]; const float a0 = lp[gt], a1 = lp[1024 + gt], a2 = lp[2048 + gt], a3 = lp[3072 + gt];
            const float mx = fmaxf(fmaxf(a0, a1), fmaxf(a2, a3)); const float e0 = expf(a0 - mx), e1 = expf(a1 - mx), e2 = expf(a2 - mx), e3 = expf(a3 - mx); const float inv = 1.0f / (e0 + e1 + e2 + e3);
            LB[gt] = e1 * inv; LB[1024 + gt] = (e1 + e2 + e3) * inv;
        }
        conv_job(lds, 0, p.in[I_EVWIN], 1536, 1024, 1536, p.in[I_MIXG], WIN, 1024, 0, true);
    }
    GRID_BAR();
    if (p.ws == nullptr) grid.sync();

    for (int l = 0; l < 4; ++l) {
        if ((l & 1) == 0) {
            PHASE_VARS
            {
                const int fr = lane & 15, fq = lane >> 4;
                for (int tile = gw; tile < 4 * 9 * 64; tile += NGW) {
                    const int g = tile / 576, rem = tile - g * 576, ct = rem >> 6, nt = rem & 63;
                    const float* pw = (ct < 8) ? IN[I_POOLW] + ((size_t)(j * 4 + g) * 128 + 16 * ct + fr) * 128 : IN[I_POOLB] + (size_t)(j * 4 + g) * 128;
                    const bool live = (ct < 8) || (fr == 0);
                    const float* sc = IN[I_POOLS] + j * 512 + g * 128;
                    const float* wo = IN[I_EVWOUT] + ((size_t)j * 1024 + 512 + g * 128) * 1024 + 16 * nt + fr;
                    f32x4 acc = (f32x4){0.f, 0.f, 0.f, 0.f};
#pragma unroll
                    for (int kk = 0; kk < 4; ++kk) { const int d0 = 32 * kk + 8 * fq;
                        f32x4 a0 = *(const f32x4*)(pw + d0) * *(const f32x4*)(sc + d0), a1 = *(const f32x4*)(pw + d0 + 4) * *(const f32x4*)(sc + d0 + 4);
                        if (!live) { a0 = (f32x4){0.f, 0.f, 0.f, 0.f}; a1 = a0; }
                        f32x4 b0, b1;
#pragma unroll
                        for (int e = 0; e < 4; ++e) { b0[e] = wo[(size_t)(d0 + e) * 1024]; b1[e] = wo[(size_t)(d0 + 4 + e) * 1024]; }
                        acc = __builtin_amdgcn_mfma_f32_16x16x32_bf16(mk8(a0, a1), mk8(b0, b1), acc, 0, 0, 0); }
                    if (ct < 8) {
#pragma unroll
                        for (int jj = 0; jj < 4; ++jj) WTMP[(size_t)(g * 128 + 16 * ct + 4 * fq + jj) * 1024 + 16 * nt + fr] = acc[jj];
                    } else if (fq == 0) BIASP[g * 1024 + 16 * nt + fr] = acc[0];
                }
            }
            RowEvenIn R{AB, PIN, ssq_mix};
            if (sb < 1536 / 64) skinny_unit<decltype(R), 1024>(lds, HB + (size_t)MX * D, WIN, sb >> 2, sb & 3, R);
            pg8::Gemm g{HB, WIN, MX, 1536, 1024}; pg8::StaticOrder S; S.init(MX, 1536, G, bid); EpiAdapt<RowEvenIn> E{R};
            pg8::gemm_phase<EpiAdapt<RowEvenIn>, pg8::StaticOrder, true, true>(lds, g, S, E);
            if (G == 256 && bid >= 128) {
                int base = 0;
                base = conv_job(lds, base, IN[I_W1] + (size_t)l * 1024 * 4096, 4096, 1024, 4096, IN[I_MLPG] + l * 1024, W1, 1024, 0, false, 128, bid - 128);
                base = conv_job(lds, base, IN[I_W2] + (size_t)l * 4096 * 1024, 1024, 4096, 1024, nullptr, W2, 4096, 0, false, 128, bid - 128);
            }
        } else {
            PHASE_VARS
            if ((bid & 1) == 0) conv_job(lds, 0, IN[I_W2] + (size_t)l * 4096 * 1024, 1024, 4096, 1024, nullptr, W2, 4096, 0, false);
            RowOddIn R{QB, LOGF, VB, SG, ssq_mix, LB + j * 1024};
            if (sb < 4096 / 64) skinny_unit<decltype(R), 1024>(lds, HB + (size_t)MX * D, WIN, sb >> 2, sb & 3, R);
            pg8::Gemm g{HB, WIN, MX, 4096, 1024}; pg8::StaticOrder S; S.init(MX, 4096, G, bid); EpiAdapt<RowOddIn> E{R};
            pg8::gemm_phase<EpiAdapt<RowOddIn>, pg8::StaticOrder, true, true>(lds, g, S, E);
            if ((bid & 1) != 0) conv_job(lds, 0, IN[I_W2] + (size_t)l * 4096 * 1024, 1024, 4096, 1024, nullptr, W2, 4096, 0, false);
        }
        GRID_BAR();
        {
            PHASE_VARS
            if (!odd && gt < 1024) BIASC[gt] = (BIASP[gt] + BIASP[1024 + gt]) + (BIASP[2048 + gt] + BIASP[3072 + gt]);
            const int skipb = (G == 256) ? (odd ? 8 : 1) : 0, Gc = G - skipb, bc = bid - skipb;
            if (bc >= 0) {
            int base = 0;
            if (!odd) { base = conv_job(lds, base, IN[I_EVWOUT] + (size_t)j * 1024 * 1024, 1024, 512, 1024, nullptr, WOUT, 1024, 0, false, Gc, bc);
                        base = conv_job(lds, base, WTMP, 1024, 512, 1024, nullptr, WOUT, 1024, 512, false, Gc, bc);
                        }
            else base = conv_job(lds, base, IN[I_ODWOUT] + (size_t)j * 1024 * 1024, 1024, 1024, 1024, nullptr, WOUT, 1024, 0, false, Gc, bc);
            if (odd || G != 256) base = conv_job(lds, base, IN[I_W1] + (size_t)l * 1024 * 4096, 4096, 1024, 4096, IN[I_MLPG] + l * 1024, W1, 1024, 0, false, Gc, bc);
            if (!odd && G != 256) base = conv_job(lds, base, IN[I_W2] + (size_t)l * 4096 * 1024, 1024, 4096, 1024, nullptr, W2, 4096, 0, false, Gc, bc);
            }
        }
        if ((l & 1) == 0) {
            PHASE_VARS
            LAS unsigned char* TA = lds;
            LAS unsigned char* TW = lds + 96256;
            { const float* cwg = IN[I_CONVW] + (size_t)j * 31 * 512;
              for (int ch = wid; ch < 62; ch += 8) { const int tap = ch >> 1, half = ch & 1;
                  __builtin_amdgcn_global_load_lds((const unsigned*)(cwg + tap * 512 + lane * 8 + half * 4), (LAS unsigned*)(TW + ch * 1024), 16, 0, 0); } }
            for (int bi = bid; bi < 257; bi += G) {
                const int b = (bi < 256) ? (bi >> 6) : 0, tb0 = (bi < 256) ? NMETA + ((bi & 63) << 6) : 0, ntok = (bi < 256) ? 64 : 16;
                for (int r = wid; r < 94; r += 8) { const int pp = tb0 - 30 + r;
                    if (pp >= 0) __builtin_amdgcn_global_load_lds((const unsigned*)(AB + (size_t)seqrow(b, pp) * 512 + lane * 8), (LAS unsigned*)(TA + r * 1024), 16, 0, 0);
                    else *(LAS u32x4*)(TA + r * 1024 + lane * 16) = (u32x4){0u, 0u, 0u, 0u}; }
                asm volatile("s_waitcnt vmcnt(0) lgkmcnt(0)" ::: "memory"); __syncthreads();
                if (8 * wid < ntok) {
                    const int c0 = lane * 8;
                    f32x4 ya0[4], ya1[4], yb0[4], yb1[4], w0[4], w1[4];
                    { const f32x4 cb0 = *(const f32x4*)(IN[I_CONVB] + j * 512 + c0), cb1 = *(const f32x4*)(IN[I_CONVB] + j * 512 + c0 + 4);
#pragma unroll
                      for (int o = 0; o < 4; ++o) { ya0[o] = cb0; ya1[o] = cb1; yb0[o] = cb0; yb1[o] = cb1; w0[o] = (f32x4){0.f, 0.f, 0.f, 0.f}; w1[o] = w0[o]; } }
#pragma unroll 1
                    for (int i0 = 0; i0 < 36; i0 += 4) {
#pragma unroll
                        for (int ii = 0; ii < 4; ++ii) {
                            const int i = i0 + ii;
                            f32x4 t0_ = (f32x4){0.f, 0.f, 0.f, 0.f}, t1_ = t0_;
                            if (i <= 30) { t0_ = *(LAS f32x4*)(TW + (2 * i) * 1024 + lane * 16); t1_ = *(LAS f32x4*)(TW + (2 * i + 1) * 1024 + lane * 16); }
                            w0[ii] = t0_; w1[ii] = t1_;
                            f32x4 a0 = (f32x4){0.f, 0.f, 0.f, 0.f}, a1 = a0, b0 = a0, b1 = a0;
                            if (i < 34) { const u32x4 av = *(LAS u32x4*)(TA + (8 * wid + i) * 1024 + lane * 16), bv = *(LAS u32x4*)(TA + (8 * wid + 4 + i) * 1024 + lane * 16);
                                a0 = (f32x4){bflo(av.x), bfhi(av.x), bflo(av.y), bfhi(av.y)}; a1 = (f32x4){bflo(av.z), bfhi(av.z), bflo(av.w), bfhi(av.w)};
                                b0 = (f32x4){bflo(bv.x), bfhi(bv.x), bflo(bv.y), bfhi(bv.y)}; b1 = (f32x4){bflo(bv.z), bfhi(bv.z), bflo(bv.w), bfhi(bv.w)}; }
#pragma unroll
                            for (int o = 0; o < 4; ++o) { ya0[o] += w0[(ii - o) & 3] * a0; ya1[o] += w1[(ii - o) & 3] * a1; yb0[o] += w0[(ii - o) & 3] * b0; yb1[o] += w1[(ii - o) & 3] * b1; }
                        }
                    }
                    const float* lg = IN[I_LNG] + j * 512 + c0; const float* lbp = IN[I_LNB] + j * 512 + c0;
                    const f32x4 g0 = *(const f32x4*)lg, g1 = *(const f32x4*)(lg + 4), bb0 = *(const f32x4*)lbp, bb1 = *(const f32x4*)(lbp + 4);
#pragma unroll
                    for (int o = 0; o < 8; ++o) {
                        const int r = seqrow(b, tb0 + 8 * wid + o);
                        const f32x4 y0 = (o < 4) ? ya0[o & 3] : yb0[o & 3], y1 = (o < 4) ? ya1[o & 3] : yb1[o & 3];
                        const float s_ = ((y0[0] + y0[1]) + (y0[2] + y0[3])) + ((y1[0] + y1[1]) + (y1[2] + y1[3]));
                        const float mu = wave_sum(s_) * (1.0f / 512.0f);
                        const f32x4 d0 = y0 - mu, d1 = y1 - mu; const f32x4 qq = d0 * d0 + d1 * d1;
                        const float var = wave_sum((qq[0] + qq[1]) + (qq[2] + qq[3])) * (1.0f / 512.0f);
                        const float rs = rsqrtf(var + EPS);
                        f32x4 z0 = d0 * rs * g0 + bb0, z1 = d1 * rs * g1 + bb1;
                        z0 = z0 * sigm4(z0); z1 = z1 * sigm4(z1);
                        *(u32x4*)(CAT + (size_t)r * 1024 + c0) = pack8(z0, z1);
                    }
                }
                __syncthreads();
                for (int r = wid; r < 79; r += 8) { const int pp = tb0 - 15 + r;
                    if (pp >= 0) __builtin_amdgcn_global_load_lds((const unsigned*)(PIN + (size_t)seqrow(b, pp) * 512 + lane * 8), (LAS unsigned*)(TA + r * 1024), 16, 0, 0);
                    else *(LAS u32x4*)(TA + r * 1024 + lane * 16) = (u32x4){0u, 0u, 0u, 0u}; }
                asm volatile("s_waitcnt vmcnt(0) lgkmcnt(0)" ::: "memory"); __syncthreads();
                for (int wi = wid; wi < (ntok >> 3) * 4; wi += 8) {
                    const int q = wi >> 2, g = wi & 3, pw = 2 << g, c = g * 128 + 2 * lane;
                    f32x2 pv[23];
#pragma unroll
                    for (int i = 0; i < 23; ++i) { pv[i] = (f32x2){0.f, 0.f};
                        if (i >= 16 - pw) { const unsigned w = *(LAS unsigned*)(TA + (8 * q + i) * 1024 + g * 256 + lane * 4); pv[i] = (f32x2){bflo(w), bfhi(w)}; } }
#pragma unroll
                    for (int o = 0; o < 8; ++o) { f32x2 sm = (f32x2){0.f, 0.f};
#pragma unroll
                        for (int ii = 0; ii < 16; ++ii) if (ii < pw) sm += pv[15 + o - ii];
                        const int t = tb0 + 8 * q + o; const float inv = 1.0f / (float)((t + 1 < pw) ? (t + 1) : pw);
                        const f32x2 d = sm * inv - pv[15 + o];
                        *(unsigned*)(CAT + (size_t)seqrow(b, t) * 1024 + 512 + c) = cvt_pk_bf16(d[0], d[1]); }
                }
                __syncthreads();
            }
        } else {
            PHASE_VARS
            LAS float* Lb = (LAS float*)lds;
            LAS bf16_t* Lkb = (LAS bf16_t*)(lds + 33792);
            LAS bf16_t* Lq = (LAS bf16_t*)(lds + 51200);
            LAS bf16_t* LvT = (LAS bf16_t*)(lds + 68608);
            LAS float* Lraw = (LAS float*)(lds + 87040);
            LAS bf16_t* LP = (LAS bf16_t*)(lds + 87040);
            LAS bf16_t* LKdT = (LAS bf16_t*)(lds + 120832);
            const int fr = lane & 15, fq = lane >> 4;
            u32x4 pl[2], pq[2], pvv[2];
#define PA_ROW(lr_) (meta_ ? ((lr_) >= 48 ? MX + (lr_) - 48 : -1) : cidx_ * 64 + (lr_))
#define PA_ISSUE_L(it_, tid) do { const int cidx_ = (it_) >> 3, hc_ = ((it_) & 7) * 128; const bool meta_ = (cidx_ == 256); \
                _Pragma("unroll") for (int i = 0; i < 2; ++i) { const int e = tid + 512 * i, lr = e >> 4, c8 = (e & 15) * 8; const int gr = PA_ROW(lr); \
                    pl[i] = (u32x4){0u, 0u, 0u, 0u}; if (gr >= 0) pl[i] = *(const u32x4*)(LOGF + (size_t)gr * 1024 + hc_ + c8); } } while (0)
#define PA_ISSUE_QV(it_, tid) do { const int cidx_ = (it_) >> 3, hc_ = ((it_) & 7) * 128; const bool meta_ = (cidx_ == 256); \
                _Pragma("unroll") for (int i = 0; i < 2; ++i) { const int e = tid + 512 * i; \
                    { const int lr = e >> 4, c8 = (e & 15) * 8; const int gr = PA_ROW(lr); pq[i] = (u32x4){0u, 0u, 0u, 0u}; if (gr >= 0) pq[i] = *(const u32x4*)(QB + (size_t)gr * 1024 + hc_ + c8); } \
                    { const int lr = e & 63, c8 = (e >> 6) * 8; const int gr = PA_ROW(lr); pvv[i] = (u32x4){0u, 0u, 0u, 0u}; if (gr >= 0) pvv[i] = *(const u32x4*)(VB + (size_t)gr * 1024 + hc_ + c8); } } } while (0)
            if (bid < NCH) PA_ISSUE_L(bid, tid);
            for (int it = bid; it < NCH; it += G) {
                int tl = tid; asm volatile("" : "+v"(tl));
                const int lanel = tl & 63, frl = lanel & 15, fql = lanel >> 4, widl = __builtin_amdgcn_readfirstlane(tl >> 6);
                PA_ISSUE_QV(it, tl);
                const int cidx = it >> 3, hc = (it & 7) * 128; const bool meta = (cidx == 256);
#pragma unroll
                for (int i = 0; i < 2; ++i) { const int e = tl + 512 * i, lr = e >> 4, c8 = (e & 15) * 8; const u32x4 lw = pl[i];
                    *(LAS f32x4*)(Lraw + lr * 132 + c8) = (f32x4){bflo(lw.x), bfhi(lw.x), bflo(lw.y), bfhi(lw.y)}; *(LAS f32x4*)(Lraw + lr * 132 + c8 + 4) = (f32x4){bflo(lw.z), bfhi(lw.z), bflo(lw.w), bfhi(lw.w)}; }
                __syncthreads();
                if (it + G < NCH) PA_ISSUE_L(it + G, tl);
                { const int col = tl & 127, sc = tl >> 7; float pre = 0.f, tot = 0.f;
#pragma unroll 4
                  for (int r = 0; r < 64; ++r) { const float x = Lraw[r * 132 + col]; tot += x; if (r < 16 * sc) pre = tot; }
                  float run = pre;
#pragma unroll
                  for (int r = 0; r < 16; ++r) { const int row = 16 * sc + r; const float lf = Lraw[row * 132 + col]; run += lf; Lb[row * 132 + col] = run;
                      const float kf = 1.0f - __expf(lf); Lkb[row * 136 + col] = f2bf(kf); LKdT[col * 72 + row] = f2bf(kf * __expf(tot - run)); }
                  if (sc == 3) DL[(size_t)it * 128 + col] = __expf(tot); }
#pragma unroll
                for (int i = 0; i < 2; ++i) { const int e = tl + 512 * i;
                    { const int lr = e >> 4, c8 = (e & 15) * 8; *(LAS u32x4*)(Lq + lr * 136 + c8) = pq[i]; }
                    { const int lr = e & 63, c8 = (e >> 6) * 8; const u32x4 vv = pvv[i];
                      LvT[(c8 + 0) * 72 + lr] = (bf16_t)(vv.x & 0xffffu); LvT[(c8 + 1) * 72 + lr] = (bf16_t)(vv.x >> 16); LvT[(c8 + 2) * 72 + lr] = (bf16_t)(vv.y & 0xffffu); LvT[(c8 + 3) * 72 + lr] = (bf16_t)(vv.y >> 16);
                      LvT[(c8 + 4) * 72 + lr] = (bf16_t)(vv.z & 0xffffu); LvT[(c8 + 5) * 72 + lr] = (bf16_t)(vv.z >> 16); LvT[(c8 + 6) * 72 + lr] = (bf16_t)(vv.w & 0xffffu); LvT[(c8 + 7) * 72 + lr] = (bf16_t)(vv.w >> 16); } }
                __syncthreads();
#pragma unroll
                for (int i = 0; i < 2; ++i) { const int e = tl + 512 * i, lr = e >> 4, c8 = (e & 15) * 8; const int gr = meta ? (lr >= 48 ? MX + lr - 48 : -1) : cidx * 64 + lr;
                    if (gr >= 0) { const u32x4 qv = *(LAS u32x4*)(Lq + lr * 136 + c8); const f32x4 e0 = exp4(*(LAS f32x4*)(Lb + lr * 132 + c8)), e1 = exp4(*(LAS f32x4*)(Lb + lr * 132 + c8 + 4));
                        const f32x4 a0 = (f32x4){bflo(qv.x), bfhi(qv.x), bflo(qv.y), bfhi(qv.y)} * e0, a1 = (f32x4){bflo(qv.z), bfhi(qv.z), bflo(qv.w), bfhi(qv.w)} * e1;
                        *(u32x4*)(QB + (size_t)gr * 1024 + hc + c8) = pack8(a0, a1); } }
                for (int idx = widl; idx < 10; idx += 8) {
                    const int i = idx >= 6 ? 3 : (idx >= 3 ? 2 : (idx >= 1 ? 1 : 0)), jb = idx - (i * (i + 1)) / 2;
                    const int t = 16 * i + frl, s_ = 16 * jb + frl;
                    f32x4 acc = (f32x4){0.f, 0.f, 0.f, 0.f};
#pragma unroll 1
                    for (int kk = 0; kk < 4; ++kk) { const int c = 32 * kk + 8 * fql;
                        f32x4 B0 = (f32x4){0.f, 0.f, 0.f, 0.f}, B1 = B0; if (i > 0) { B0 = *(LAS f32x4*)(Lb + (16 * i - 1) * 132 + c); B1 = *(LAS f32x4*)(Lb + (16 * i - 1) * 132 + c + 4); }
                        const f32x4 bt0 = *(LAS f32x4*)(Lb + t * 132 + c), bt1 = *(LAS f32x4*)(Lb + t * 132 + c + 4), bs0 = *(LAS f32x4*)(Lb + s_ * 132 + c), bs1 = *(LAS f32x4*)(Lb + s_ * 132 + c + 4);
                        const u32x4 qv = *(LAS u32x4*)(Lq + t * 136 + c), kv = *(LAS u32x4*)(Lkb + s_ * 136 + c);
                        const f32x4 m80 = (f32x4){80.f, 80.f, 80.f, 80.f};
                        const f32x4 qa0 = (f32x4){bflo(qv.x), bfhi(qv.x), bflo(qv.y), bfhi(qv.y)} * exp4(bt0 - B0), qa1 = (f32x4){bflo(qv.z), bfhi(qv.z), bflo(qv.w), bfhi(qv.w)} * exp4(bt1 - B1);
                        const f32x4 ka0 = (f32x4){bflo(kv.x), bfhi(kv.x), bflo(kv.y), bfhi(kv.y)} * exp4(__builtin_elementwise_min(B0 - bs0, m80)), ka1 = (f32x4){bflo(kv.z), bfhi(kv.z), bflo(kv.w), bfhi(kv.w)} * exp4(__builtin_elementwise_min(B1 - bs1, m80));
                        acc = __builtin_amdgcn_mfma_f32_16x16x32_bf16(mk8(ka0, ka1), mk8(qa0, qa1), acc, 0, 0, 0); }
                    if (i == jb) {
#pragma unroll
                        for (int jj = 0; jj < 4; ++jj) if (4 * fql + jj > frl) acc[jj] = 0.f; }
                    u32x2 w; w.x = cvt_pk_bf16(acc[0], acc[1]); w.y = cvt_pk_bf16(acc[2], acc[3]);
                    *(LAS u32x2*)(LP + t * 72 + 16 * jb + 4 * fql) = w;
                }
                if (widl >= 2) { const int u = widl - 2, i = u < 3 ? 0 : (u < 5 ? 1 : 2), jb = u < 3 ? u + 1 : (u < 5 ? u - 1 : 3);
                    *(LAS u32x2*)(LP + (16 * i + frl) * 72 + 16 * jb + 4 * fql) = (u32x2){0u, 0u}; }
                __syncthreads();
                {
#pragma unroll
                    for (int i = 0; i < 4; ++i) {
                        f32x4 acc = (f32x4){0.f, 0.f, 0.f, 0.f};
#pragma unroll
                        for (int ss = 0; ss < 2; ++ss) if (ss == 0 || i >= 2) {
                            const bf16x8 a = *(LAS bf16x8*)(LvT + (16 * widl + frl) * 72 + 32 * ss + 8 * fql), bb = *(LAS bf16x8*)(LP + (16 * i + frl) * 72 + 32 * ss + 8 * fql);
                            acc = __builtin_amdgcn_mfma_f32_16x16x32_bf16(a, bb, acc, 0, 0, 0); }
                        const int lr = 16 * i + frl; const int gr = meta ? (lr >= 48 ? MX + lr - 48 : -1) : cidx * 64 + lr;
                        if (gr >= 0) { u32x2 w; w.x = cvt_pk_bf16(acc[0], acc[1]); w.y = cvt_pk_bf16(acc[2], acc[3]); *(u32x2*)(VB + (size_t)gr * 1024 + hc + 16 * widl + 4 * fql) = w; }
                    }
                    bf16_t* ut = UT + (size_t)it * 16384;
                    const bf16x8 v0 = *(LAS bf16x8*)(LvT + (16 * widl + frl) * 72 + 8 * fql), v1 = *(LAS bf16x8*)(LvT + (16 * widl + frl) * 72 + 32 + 8 * fql);
#pragma unroll
                    for (int kb = 0; kb < 8; ++kb) {
                        const bf16x8 a0 = *(LAS bf16x8*)(LKdT + (16 * kb + frl) * 72 + 8 * fql), a1 = *(LAS bf16x8*)(LKdT + (16 * kb + frl) * 72 + 32 + 8 * fql);
                        f32x4 acc = (f32x4){0.f, 0.f, 0.f, 0.f};
                        acc = __builtin_amdgcn_mfma_f32_16x16x32_bf16(a0, v0, acc, 0, 0, 0); acc = __builtin_amdgcn_mfma_f32_16x16x32_bf16(a1, v1, acc, 0, 0, 0);
                        u32x2 w; w.x = cvt_pk_bf16(acc[0], acc[1]); w.y = cvt_pk_bf16(acc[2], acc[3]);
                        *(u32x2*)(ut + (16 * widl + frl) * 128 + 16 * kb + 4 * fql) = w;
                    }
                }
                __syncthreads();
            }
#undef PA_ISSUE_L
#undef PA_ISSUE_QV
#undef PA_ROW
        }
        GRID_BAR();
        if (l & 1) {
            {
                PHASE_VARS
                for (int rep = 0; rep < 1 + ((PROBE_MIX >> 3) & 1); ++rep) {
                const bool dry = (rep < ((PROBE_MIX >> 3) & 1)) && (((size_t)p.ws & 1) == 0);
                for (int g2 = gt; g2 < 32 * 4096; g2 += NGT) {
                    const int e4 = g2 & 4095, bh = g2 >> 12, b = bh >> 3, h = bh & 7, k4 = (e4 & 31) * 4;
                    const u32x2 m0 = *(const u32x2*)(UT + (size_t)(2048 + h) * 16384 + e4 * 4);
                    f32x4 S = (f32x4){bflo(m0.x), bfhi(m0.x), bflo(m0.y), bfhi(m0.y)};
                    for (int n0 = 0; n0 < 64; n0 += 16) {
                        u32x2 U[16]; f32x4 d[16];
#pragma unroll
                        for (int u = 0; u < 16; ++u) { const size_t item = (size_t)((b * 64 + n0 + u) * 8 + h); U[u] = *(const u32x2*)(UT + item * 16384 + e4 * 4); d[u] = *(const f32x4*)(DL + item * 128 + k4); }
#pragma unroll
                        for (int u = 0; u < 16; ++u) { const size_t item = (size_t)((b * 64 + n0 + u) * 8 + h);
                            u32x2 w; w.x = cvt_pk_bf16(S[0], S[1]); w.y = cvt_pk_bf16(S[2], S[3]); if (dry) w = U[u]; *(u32x2*)(UT + item * 16384 + e4 * 4) = w;
                            S = d[u] * S + (f32x4){bflo(U[u].x), bfhi(U[u].x), bflo(U[u].y), bfhi(U[u].y)}; }
                    }
                }
                }
            }
            GRID_BAR();
            {
                PHASE_VARS
                const int fr = lane & 15, fq = lane >> 4;
                const float* gg = IN[I_GNORM] + j * 128;
                PASSC_ITEMS(0, 4104);
            }
            GRID_BAR();
        }
        {
            PHASE_VARS
            const bf16_t* A = odd ? YB : CAT;
            RowRes R{HB, ssq_mlp, odd ? nullptr : BIASC, 1.0f};
            if (sb < 1024 / 64) skinny_unit<decltype(R), 1024>(lds, A + (size_t)MX * D, WOUT, sb >> 2, sb & 3, R);
            pg8::Gemm g{A, WOUT, MX, 1024, 1024}; pg8::StaticOrder S; S.init(MX, 1024, G, bid); EpiAdapt<RowRes> E{R};
            pg8::gemm_phase<EpiAdapt<RowRes>, pg8::StaticOrder, true, true>(lds, g, S, E);
        }
        GRID_BAR();
        for (int rep = 0; rep < 1 + PROBE_MLP; ++rep) {
            PHASE_VARS
#define G3_CONV() do { int base = 0; \
                if (l < 3) { if (!odd) base = conv_job(lds, base, IN[I_ODWIN] + (size_t)j * 1024 * 4096, 4096, 1024, 4096, IN[I_MIXG] + (l + 1) * 1024, WIN, 1024, 0, false); \
                             else base = conv_job(lds, base, IN[I_EVWIN] + (size_t)(j + 1) * 1024 * 1536, 1536, 1024, 1536, IN[I_MIXG] + (l + 1) * 1024, WIN, 1024, 0, true); } } while (0)
            if (rep == 0 && (bid & 1) == 0) G3_CONV();
            RowMlpUp R{MB, ssq_mlp};
            if (sb < 4096 / 64) skinny_unit<decltype(R), 1024>(lds, HB + (size_t)MX * D, W1, sb >> 2, sb & 3, R);
            pg8::Gemm g{HB, W1, MX, 4096, 1024}; pg8::StaticOrder S; S.init(MX, 4096, G, bid); EpiAdapt<RowMlpUp> E{R};
            pg8::gemm_phase<EpiAdapt<RowMlpUp>, pg8::StaticOrder, true, true>(lds, g, S, E);
            if (rep == 0 && (bid & 1) != 0) G3_CONV();
#undef G3_CONV
            if (rep < PROBE_MLP) GRID_BAR();
        }
        GRID_BAR();
        for (int rep = 0; rep < 1 + PROBE_MLP; ++rep) {
            PHASE_VARS
            const float gain = (rep < PROBE_MLP) ? (((size_t)p.ws & 1) ? 1.0f : 0.0f) : 1.0f;
            RowRes R{HB, ssq_next, nullptr, gain};
            if (sb < 1024 / 64) skinny_unit<decltype(R), 4096>(lds, MB + (size_t)MX * DFF, W2, sb >> 2, sb & 3, R);
            pg8::Gemm g{MB, W2, MX, 1024, 4096}; pg8::StaticOrder S; S.init(MX, 1024, G, bid); EpiAdapt<RowRes> E{R};
            pg8::gemm_phase<EpiAdapt<RowRes>, pg8::StaticOrder, true, true>(lds, g, S, E);
            if (rep < PROBE_MLP) GRID_BAR();
        }
        GRID_BAR();
    }
    {
        const int l = 0; PHASE_VARS
        const float* fg = IN[I_FING];
        for (int r = gw; r < MX; r += NGW) {
            const float part = (lane < 16) ? SSQ[(size_t)lane * MR + r] : 0.f;
            float s4 = part; s4 += __shfl_xor(s4, 1); s4 += __shfl_xor(s4, 2);
            s4 += __shfl_xor(s4, 4); s4 += __shfl_xor(s4, 8);
            const float tot = __shfl(s4, 0);
            const float rinv = rsqrtf(tot * (1.0f / D) + EPS);
#pragma unroll
            for (int i = 0; i < 4; ++i) { const int c = lane * 4 + 256 * i; const u32x2 hw = *(const u32x2*)(HB + (size_t)r * D + c); f32x4 v = (f32x4){bflo(hw.x), bfhi(hw.x), bflo(hw.y), bfhi(hw.y)}; v = v * rinv * *(const f32x4*)(fg + c); __builtin_nontemporal_store(v, (f32x4*)(((float*)IN[20]) + (size_t)r * D + c)); }
        }
    }
}

extern "C" void kernel_launch(void* const* d_in, const int* in_sizes, int n_in, void* d_out, int out_size, void* d_ws, size_t ws_size, hipStream_t stream) {
    static int grid = 0;
    if (grid == 0) {
        int dev = 0, cus = 0, per_cu = 0;
        if (n_in != 20 || ws_size < WS_END) { fprintf(stderr, "kernel_launch: unexpected n_in %d / ws_size %zu (need %zu)\n", n_in, ws_size, (size_t)WS_END); grid = -1; return; }
        (void)hipGetDevice(&dev);
        (void)hipDeviceGetAttribute(&cus, hipDeviceAttributeMultiprocessorCount, dev);
        if (hipFuncSetAttribute((const void*)fwd, hipFuncAttributeMaxDynamicSharedMemorySize, LDS_BYTES) != hipSuccess) { fprintf(stderr, "kernel_launch: hipFuncSetAttribute failed\n"); grid = -1; return; }
        if (hipOccupancyMaxActiveBlocksPerMultiprocessor(&per_cu, (const void*)fwd, 512, LDS_BYTES) != hipSuccess || per_cu < 1) { fprintf(stderr, "kernel_launch: occupancy query says %d\n", per_cu); per_cu = 1; }
        (void)hipGetLastError();
        grid = cus > 0 ? cus : 256;
    }
    if (grid < 0) return;
    Params p{};
    for (int i = 0; i < 20; ++i) p.in[i] = (const float*)d_in[i];
    p.out = (float*)d_out; p.ws = (unsigned char*)d_ws;
    if (hipMemsetAsync((char*)d_ws + WS_MISC + MISC_BAR, 0, XCD_BAR_WORDS * 4, stream) != hipSuccess) { fprintf(stderr, "kernel_launch: memset of the barrier words failed\n"); return; }
    void* args[] = {&p};
    hipError_t e = hipLaunchCooperativeKernel((const void*)fwd, dim3(grid), dim3(512), args, LDS_BYTES, stream);
    if (e != hipSuccess) fprintf(stderr, "kernel_launch: cooperative launch failed: %s (grid %d)\n", hipGetErrorString(e), grid);
}
```

```cpp
#include <hip/hip_runtime.h>
#include <hip/hip_cooperative_groups.h>
#include <cstdio>
#include <cstdint>
namespace cg = cooperative_groups;

#define LAS __attribute__((address_space(3)))
typedef unsigned short bf16_t;
typedef short bf16x8 __attribute__((ext_vector_type(8)));
typedef float f32x4 __attribute__((ext_vector_type(4)));
typedef float f32x2 __attribute__((ext_vector_type(2)));
typedef unsigned u32x4 __attribute__((ext_vector_type(4)));
typedef unsigned u32x2 __attribute__((ext_vector_type(2)));

constexpr int D = 1024, SEQ = 4096, NMETA = 16, MX = 16384, MR = 16400, DFF = 4096;
constexpr float EPS = 1e-6f;
constexpr int LDS_BYTES = 163840;

constexpr size_t MiB = 1u << 20;
constexpr size_t WS_WIN = 0, WS_WOUT = 8 * MiB, WS_W1 = 10 * MiB, WS_W2 = 18 * MiB, WS_WTMP = 26 * MiB  , WS_SSQ = 28 * MiB  , WS_MISC = 30 * MiB;
constexpr size_t MISC_LB = 0;
constexpr size_t MISC_BIASC = MISC_LB + 2 * 1024 * 4;
constexpr size_t MISC_BIASP = MISC_BIASC + 1024 * 4;
constexpr size_t MISC_HMETA = MISC_BIASP + 4 * 1024 * 4;
constexpr size_t MISC_BAR = MISC_HMETA + 16 * 1024 * 4;
constexpr size_t MISC_INPTR = MISC_BAR + 3456 * 4;
static_assert(MISC_INPTR + 32 * 8 <= MiB && 16 * (size_t)MR * 4 <= 2 * MiB, "misc");
constexpr size_t RB16 = (size_t)MR * 1024 * 2, RB32 = (size_t)MR * 1024 * 4;
constexpr size_t WS_HB = 31 * MiB;
constexpr int NCH = 2056;
constexpr size_t WS_UT = WS_HB + RB16;
constexpr size_t WS_DL = WS_WTMP;
constexpr size_t WS_Q = WS_UT + (size_t)NCH * 32768, WS_V = WS_Q + RB16, WS_SG = WS_V + RB16, WS_LOGF = WS_SG + RB16;
constexpr size_t WS_Y = WS_LOGF;
constexpr size_t WS_AR = WS_HB + RB16;
constexpr size_t WS_A = WS_AR, WS_PIN = WS_A + RB16 / 2, WS_CAT = WS_PIN + RB16 / 2;
constexpr size_t WS_M = WS_AR;
constexpr size_t WS_END = WS_LOGF + RB16;
static_assert(WS_END <= 256 * MiB && WS_M + 4 * RB16 <= 256 * MiB && (size_t)NCH * 512 <= 2 * MiB, "ws map");

typedef __bf16 bf16x2_t __attribute__((ext_vector_type(2)));
__device__ __forceinline__ unsigned cvt_pk_bf16(float lo, float hi) { const f32x2 v = {lo, hi}; const bf16x2_t r = __builtin_convertvector(v, bf16x2_t); return __builtin_bit_cast(unsigned, r); }
__device__ __forceinline__ float bf2f(unsigned short b) { return __uint_as_float(((unsigned)b) << 16); }
__device__ __forceinline__ float bflo(unsigned w) { return __uint_as_float(w << 16); }
__device__ __forceinline__ float bfhi(unsigned w) { return __uint_as_float(w & 0xffff0000u); }
__device__ __forceinline__ float wave_sum(float v) {
#pragma unroll
    for (int o = 32; o >= 1; o >>= 1) v += __shfl_xor(v, o);
    return v;
}
__device__ __forceinline__ float sigm(float x) { return 1.0f / (1.0f + __expf(-x)); }
__device__ __forceinline__ f32x4 sigm4(f32x4 x) { return (f32x4){sigm(x[0]), sigm(x[1]), sigm(x[2]), sigm(x[3])}; }
__device__ __forceinline__ bf16_t f2bf(float x) { return (bf16_t)(cvt_pk_bf16(x, 0.f) & 0xffffu); }
__device__ __forceinline__ u32x4 pack8(f32x4 a, f32x4 b) { u32x4 w; w.x = cvt_pk_bf16(a[0], a[1]); w.y = cvt_pk_bf16(a[2], a[3]); w.z = cvt_pk_bf16(b[0], b[1]); w.w = cvt_pk_bf16(b[2], b[3]); return w; }

__device__ __forceinline__ bf16x8 mk8(f32x4 a, f32x4 b) { const u32x4 w = pack8(a, b); return __builtin_bit_cast(bf16x8, w); }
__device__ __forceinline__ f32x4 exp4(f32x4 x) { return (f32x4){__expf(x[0]), __expf(x[1]), __expf(x[2]), __expf(x[3])}; }

namespace pg8 {
#define PG8_LAS __attribute__((address_space(3)))
constexpr int BM = 256, BK = 64, HALF = 128, HTB = HALF * BK * 2, STAGE_BYTES = 8 * HTB, NXCD = 8, WGM = 8;
__host__ __device__ __forceinline__ int lds_byte(int r, int c) { const int st = (r >> 4) * 2 + (c >> 5), rr = r & 15, cc = c & 31, ob = rr * 64 + cc * 2; return st * 1024 + (ob ^ (((ob >> 9) & 1) << 5)); }
__host__ __device__ __forceinline__ void stage_rc(int b, int& R, int& C) { const int st = b / 1024, sb = b % 1024, swz = sb ^ (((sb >> 9) & 1) << 5); R = (st >> 1) * 16 + swz / 64; C = (st & 1) * 32 + (swz % 64) / 2; }
__host__ __device__ __forceinline__ int perm32(int rho) { const int n = rho >> 4, i = rho & 15; return 8 * (i >> 2) + 4 * n + (i & 3); }
struct Unit { int pm, pn; };
struct Gemm { const bf16_t* A; const bf16_t* Bt; int M, N, K; };
struct StaticOrder {
    int nM, nN, nwg, G, c;
    __host__ __device__ void init(int M, int N, int G_, int c_) { nM = M / BM; nN = N / BM; nwg = nM * nN; G = G_; c = c_; }
    __host__ __device__ bool next(int i, Unit& u) const {
        const long L = (long)i * G + c; if (L >= nwg) return false;
        int wgid = (int)L; { const int q = nwg / NXCD, r = nwg % NXCD, xcd = wgid % NXCD, off = wgid / NXCD; wgid = (xcd < r ? xcd * (q + 1) : r * (q + 1) + (xcd - r) * q) + off; }
        const int nig = WGM * nN, gid = wgid / nig, fm = gid * WGM, gsz = (nM - fm) < WGM ? (nM - fm) : WGM;
        u.pm = fm + ((wgid % nig) % gsz); u.pn = (wgid % nig) / gsz; return true;
    }
    __device__ __forceinline__ void a_ready(const Unit&) const {}
    __device__ __forceinline__ void done(const Unit&) const {}
};

template <class Epi, class Sched, bool ALIGN_EPI = false, bool SP2 = false>
__device__ __forceinline__ void gemm_phase(PG8_LAS unsigned char* lds, const Gemm g, const Sched& S, const Epi& E) {
    int tid = threadIdx.x; asm volatile("" : "+v"(tid));
    const int wid = __builtin_amdgcn_readfirstlane(tid >> 6), lane = tid & 63, wr = wid >> 2, wc = wid & 3, fr = lane & 15, fq = lane >> 4;
    const int K = g.K, nt = K / BK;
    unsigned voffA[2], voffB[2];
#pragma unroll
    for (int i = 0; i < 2; ++i) { int R, C; stage_rc(tid * 16 + i * 8192, R, C); const int Rb = Epi::PERM ? ((R & ~31) + perm32(R & 31)) : R;
        voffA[i] = (unsigned)(R * K + C) * 2u; voffB[i] = (unsigned)(Rb * K + C) * 2u; }
    const size_t kstep = (size_t)(BK * 2);
    const size_t hstep = (size_t)HALF * K * 2;
    const size_t tstep = 2 * hstep;
    const unsigned ldsw = (unsigned)wid * 1024u;
    const int aoff = lds_byte(wr * 64 + fr, fq * 8), boff = lds_byte(wc * 32 + fr, fq * 8);
#define PG8_SA(b, h) (((b) * 2 + (h)) * HTB)
#define PG8_SB(b, h) ((4 + (b) * 2 + (h)) * HTB)
#define PG8_STAGE(bufoff, gbase, voff) do { _Pragma("unroll") for (int _i = 0; _i < 2; ++_i) \
        __builtin_amdgcn_global_load_lds((const unsigned*)((const char*)(gbase) + (voff)[_i]), (PG8_LAS unsigned*)(lds + (bufoff) + ldsw + _i * 8192), 16, 0, 0); } while (0)
#define PG8_LDA(dst, b, h) do { _Pragma("unroll") for (int m = 0; m < 4; ++m) _Pragma("unroll") for (int k = 0; k < 2; ++k) dst[m][k] = *(const PG8_LAS bf16x8*)(lds + PG8_SA(b, h) + aoff + m * 2048 + k * 1024); } while (0)
#define PG8_LDB(dst, b, h) do { _Pragma("unroll") for (int n = 0; n < 2; ++n) _Pragma("unroll") for (int k = 0; k < 2; ++k) dst[n][k] = *(const PG8_LAS bf16x8*)(lds + PG8_SB(b, h) + boff + n * 2048 + k * 1024); } while (0)
#define PG8_MMA(ai, bj, At, Bt) do { __builtin_amdgcn_s_setprio(1); _Pragma("unroll") for (int m = 0; m < 4; ++m) _Pragma("unroll") for (int n = 0; n < 2; ++n) _Pragma("unroll") for (int k = 0; k < 2; ++k) \
        acc[ai][bj][m][n] = __builtin_amdgcn_mfma_f32_16x16x32_bf16(Bt[n][k], At[m][k], acc[ai][bj][m][n], 0, 0, 0); __builtin_amdgcn_s_setprio(0); } while (0)
#define PG8_WAIT_V(n) asm volatile("s_waitcnt vmcnt(" #n ")" ::: "memory")
#define PG8_WAIT_L(n) asm volatile("s_waitcnt lgkmcnt(" #n ")" ::: "memory")
#define PG8_BAR __builtin_amdgcn_s_barrier()
#define PG8_SCHED __builtin_amdgcn_sched_barrier(0)
    Unit cur, nxt; int ui = 0;
    if (!S.next(0, cur)) return;
    f32x4 acc[2][2][4][2];
#pragma unroll
    for (int a = 0; a < 2; ++a)
#pragma unroll
        for (int b = 0; b < 2; ++b)
#pragma unroll
            for (int m = 0; m < 4; ++m)
#pragma unroll
                for (int n = 0; n < 2; ++n) acc[a][b][m][n] = (f32x4){0.f, 0.f, 0.f, 0.f};
    bf16x8 At[4][2], B0[2][2], B1[2][2];
    const char* cA = (const char*)g.A + (size_t)cur.pm * tstep; const char* cB = (const char*)g.Bt + (size_t)cur.pn * tstep;
    S.a_ready(cur);
    if constexpr (SP2) {
        PG8_STAGE(PG8_SB(0, 0), cB, voffB); PG8_STAGE(PG8_SB(0, 1), cB + hstep, voffB); PG8_STAGE(PG8_SA(0, 0), cA, voffA); PG8_STAGE(PG8_SA(0, 1), cA + hstep, voffA);
        if (wr == 1) PG8_BAR;
        PG8_WAIT_V(2); PG8_BAR;
        PG8_STAGE(PG8_SB(1, 0), cB + kstep, voffB); PG8_STAGE(PG8_SA(1, 0), cA + kstep, voffA); PG8_STAGE(PG8_SB(1, 1), cB + hstep + kstep, voffB);
        PG8_WAIT_V(6); PG8_BAR;
    } else {
        PG8_STAGE(PG8_SB(0, 0), cB, voffB); PG8_STAGE(PG8_SA(0, 0), cA, voffA); PG8_STAGE(PG8_SB(0, 1), cB + hstep, voffB); PG8_STAGE(PG8_SA(0, 1), cA + hstep, voffA);
        if (wr == 1) PG8_BAR;
        PG8_WAIT_V(4); PG8_BAR;
        PG8_STAGE(PG8_SB(1, 0), cB + kstep, voffB); PG8_STAGE(PG8_SA(1, 0), cA + kstep, voffA); PG8_STAGE(PG8_SB(1, 1), cB + hstep + kstep, voffB);
        PG8_WAIT_V(6); PG8_BAR;
    }
    for (;;) {
        const bool has_next = S.next(ui + 1, nxt);
        const char* nA = has_next ? (const char*)g.A + (size_t)nxt.pm * tstep : cA; const char* nB = has_next ? (const char*)g.Bt + (size_t)nxt.pn * tstep : cB;
        for (int t = 0; t < nt; t += 2) {
            const bool last = (t == nt - 2);
            const char* a1 = cA + (size_t)(t + 1) * kstep;
            const char* a2 = last ? nA : cA + (size_t)(t + 2) * kstep; const char* b2 = last ? nB : cB + (size_t)(t + 2) * kstep;
            const char* a3 = a2 + kstep; const char* b3 = b2 + kstep;
            if (last && has_next) S.a_ready(nxt);
            if constexpr (SP2) {
            PG8_LDB(B0, 0, 0); PG8_LDB(B1, 0, 1); PG8_SCHED; PG8_LDA(At, 0, 0); PG8_STAGE(PG8_SA(1, 1), a1 + hstep, voffA);
            PG8_WAIT_V(8); PG8_WAIT_L(0); PG8_BAR; PG8_MMA(0, 0, At, B0); PG8_MMA(0, 1, At, B1); PG8_BAR; PG8_SCHED;
            PG8_LDA(At, 0, 1); PG8_STAGE(PG8_SB(0, 0), b2, voffB); PG8_STAGE(PG8_SB(0, 1), b2 + hstep, voffB); PG8_STAGE(PG8_SA(0, 0), a2, voffA);
            PG8_WAIT_V(8); PG8_WAIT_L(0); PG8_BAR; PG8_MMA(1, 0, At, B0); PG8_MMA(1, 1, At, B1); PG8_BAR; PG8_SCHED;
            PG8_LDB(B0, 1, 0); PG8_LDB(B1, 1, 1); PG8_SCHED; PG8_LDA(At, 1, 0); PG8_STAGE(PG8_SA(0, 1), a2 + hstep, voffA);
            PG8_WAIT_V(8); PG8_WAIT_L(0); PG8_BAR; PG8_MMA(0, 0, At, B0); PG8_MMA(0, 1, At, B1); PG8_BAR; PG8_SCHED;
            PG8_LDA(At, 1, 1); PG8_STAGE(PG8_SB(1, 0), b3, voffB); PG8_STAGE(PG8_SB(1, 1), b3 + hstep, voffB); PG8_STAGE(PG8_SA(1, 0), a3, voffA);
            PG8_WAIT_V(8); PG8_WAIT_L(0); PG8_BAR; PG8_MMA(1, 0, At, B0); PG8_MMA(1, 1, At, B1); PG8_BAR; PG8_SCHED;
            } else {
            PG8_LDB(B0, 0, 0); PG8_SCHED; PG8_LDA(At, 0, 0); PG8_STAGE(PG8_SA(1, 1), a1 + hstep, voffA);
            PG8_WAIT_L(8); PG8_BAR; PG8_WAIT_L(0); PG8_MMA(0, 0, At, B0); PG8_BAR; PG8_SCHED;
            PG8_LDB(B1, 0, 1); PG8_STAGE(PG8_SB(0, 0), b2, voffB);
            PG8_BAR; PG8_WAIT_L(0); PG8_MMA(0, 1, At, B1); PG8_BAR;
            PG8_LDA(At, 0, 1); PG8_STAGE(PG8_SA(0, 0), a2, voffA);
            PG8_BAR; PG8_WAIT_L(0); PG8_MMA(1, 0, At, B0); PG8_BAR; PG8_SCHED;
            PG8_STAGE(PG8_SB(0, 1), b2 + hstep, voffB);
            PG8_WAIT_V(6); PG8_BAR; PG8_MMA(1, 1, At, B1); PG8_BAR;
            PG8_LDB(B0, 1, 0); PG8_SCHED; PG8_LDA(At, 1, 0); PG8_STAGE(PG8_SA(0, 1), a2 + hstep, voffA);
            PG8_WAIT_L(8); PG8_BAR; PG8_WAIT_L(0); PG8_MMA(0, 0, At, B0); PG8_BAR; PG8_SCHED;
            PG8_LDB(B1, 1, 1); PG8_STAGE(PG8_SB(1, 0), b3, voffB);
            PG8_BAR; PG8_WAIT_L(0); PG8_MMA(0, 1, At, B1); PG8_BAR;
            PG8_LDA(At, 1, 1); PG8_STAGE(PG8_SA(1, 0), a3, voffA);
            PG8_BAR; PG8_WAIT_L(0); PG8_MMA(1, 0, At, B0); PG8_BAR; PG8_SCHED;
            PG8_STAGE(PG8_SB(1, 1), b3 + hstep, voffB);
            PG8_WAIT_V(6); PG8_BAR; PG8_MMA(1, 1, At, B1); PG8_BAR;
            }
        }
        if constexpr (ALIGN_EPI) { if (wr == 0) PG8_BAR; }
        E(acc, cur, wr, wc, fr, fq);
        if (!has_next) break;
#pragma unroll
        for (int a = 0; a < 2; ++a)
#pragma unroll
            for (int b = 0; b < 2; ++b)
#pragma unroll
                for (int m = 0; m < 4; ++m)
#pragma unroll
                    for (int n = 0; n < 2; ++n) acc[a][b][m][n] = (f32x4){0.f, 0.f, 0.f, 0.f};
        cur = nxt; cA = nA; cB = nB; ++ui;
        if constexpr (ALIGN_EPI) { if (wr == 1) PG8_BAR; }
    }
    PG8_WAIT_V(0);
    if constexpr (!ALIGN_EPI) { if (wr == 0) PG8_BAR; }
    PG8_BAR;
#undef PG8_SA
#undef PG8_SB
#undef PG8_STAGE
#undef PG8_LDA
#undef PG8_LDB
#undef PG8_MMA
#undef PG8_WAIT_V
#undef PG8_WAIT_L
#undef PG8_BAR
#undef PG8_SCHED
}
}

__device__ __forceinline__ float row_rinv(const float* ssq, int r, int fq) {
    const float* q = ssq + (size_t)(4 * fq) * MR + r;
    float s = (q[0] + q[MR]) + (q[2 * MR] + q[3 * MR]);
    s += __shfl_xor(s, 16); s += __shfl_xor(s, 32);
    return rsqrtf(s * (1.0f / D) + EPS);
}
struct RowEvenIn {
    bf16_t* Abuf; bf16_t* Pin; const float* ssq;
    __device__ __forceinline__ float prep(int r, int fq) const { return row_rinv(ssq, r, fq); }
    __device__ __forceinline__ void row(int r, int pn, int wc, int fq, f32x4 v00, f32x4 v01, f32x4 v10, f32x4 v11, float rinv) const {
        if (pn < 4) {
            const int col = 128 * pn + 32 * wc + 8 * fq;
            const f32x4 a0 = (v00 * rinv) * sigm4(v10 * rinv), a1 = (v01 * rinv) * sigm4(v11 * rinv);
            *(u32x4*)(Abuf + (size_t)r * 512 + col) = pack8(a0, a1);
        } else {
            const int col = (pn - 4) * 256 + 32 * wc + 8 * fq;
            *(u32x4*)(Pin + (size_t)r * 512 + col) = pack8(v00 * rinv, v01 * rinv);
            *(u32x4*)(Pin + (size_t)r * 512 + col + 128) = pack8(v10 * rinv, v11 * rinv);
        }
    }
};
struct RowOddIn {
    bf16_t* Q; bf16_t* LOGF; bf16_t* V; bf16_t* SG; const float* ssq; const float* lb;
    __device__ __forceinline__ float prep(int r, int fq) const { return row_rinv(ssq, r, fq); }
    __device__ __forceinline__ void row(int r, int pn, int wc, int fq, f32x4 v00, f32x4 v01, f32x4 v10, f32x4 v11, float rinv) const {
        const int type = pn >> 2, col = (pn & 3) * 256 + 32 * wc + 8 * fq;
        const size_t o = (size_t)r * 1024 + col;
        v00 = v00 * rinv; v01 = v01 * rinv; v10 = v10 * rinv; v11 = v11 * rinv;
        if (type == 0) {
            *(u32x4*)(Q + o) = pack8(v00 * sigm4(v00), v01 * sigm4(v01)); *(u32x4*)(Q + o + 128) = pack8(v10 * sigm4(v10), v11 * sigm4(v11));
        } else if (type == 1) {
            const f32x4 l00 = *(const f32x4*)(lb + col), l01 = *(const f32x4*)(lb + col + 4), l10 = *(const f32x4*)(lb + col + 128), l11 = *(const f32x4*)(lb + col + 132);
            f32x4 f00 = l00 + (1.0f - l00) * sigm4(v00), f01 = l01 + (1.0f - l01) * sigm4(v01), f10 = l10 + (1.0f - l10) * sigm4(v10), f11 = l11 + (1.0f - l11) * sigm4(v11);
#pragma unroll
            for (int j = 0; j < 4; ++j) { f00[j] = __logf(f00[j]); f01[j] = __logf(f01[j]); f10[j] = __logf(f10[j]); f11[j] = __logf(f11[j]); }
            *(u32x4*)(LOGF + o) = pack8(f00, f01); *(u32x4*)(LOGF + o + 128) = pack8(f10, f11);
        } else if (type == 2) {
            *(u32x4*)(V + o) = pack8(v00, v01); *(u32x4*)(V + o + 128) = pack8(v10, v11);
        } else {
            *(u32x4*)(SG + o) = pack8(v00 * sigm4(v00), v01 * sigm4(v01)); *(u32x4*)(SG + o + 128) = pack8(v10 * sigm4(v10), v11 * sigm4(v11));
        }
    }
};
struct RowRes {
    bf16_t* hb; float* ssq; const float* bias; float gain;
    __device__ __forceinline__ float prep(int, int) const { return 0.f; }
    __device__ __forceinline__ void row(int r, int pn, int wc, int fq, f32x4 v00, f32x4 v01, f32x4 v10, f32x4 v11, float) const {
        const int col = 256 * pn + 32 * wc + 8 * fq;
        bf16_t* hp = hb + (size_t)r * D + col;
        const u32x4 h0 = *(const u32x4*)hp, h1 = *(const u32x4*)(hp + 128);
        if (bias) { v00 += *(const f32x4*)(bias + col); v01 += *(const f32x4*)(bias + col + 4); v10 += *(const f32x4*)(bias + col + 128); v11 += *(const f32x4*)(bias + col + 132); }
        v00 = v00 * gain + (f32x4){bflo(h0.x), bfhi(h0.x), bflo(h0.y), bfhi(h0.y)}; v01 = v01 * gain + (f32x4){bflo(h0.z), bfhi(h0.z), bflo(h0.w), bfhi(h0.w)};
        v10 = v10 * gain + (f32x4){bflo(h1.x), bfhi(h1.x), bflo(h1.y), bfhi(h1.y)}; v11 = v11 * gain + (f32x4){bflo(h1.z), bfhi(h1.z), bflo(h1.w), bfhi(h1.w)};
        *(u32x4*)hp = pack8(v00, v01); *(u32x4*)(hp + 128) = pack8(v10, v11);
        const f32x4 q = v00 * v00 + v01 * v01 + v10 * v10 + v11 * v11;
        float s = (q[0] + q[1]) + (q[2] + q[3]);
        s += __shfl_xor(s, 16); s += __shfl_xor(s, 32);
        if (fq == 0) ssq[(size_t)(pn * 4 + wc) * MR + r] = s;
    }
};
struct RowMlpUp {
    bf16_t* Mb; const float* ssq;
    __device__ __forceinline__ float prep(int r, int fq) const { return row_rinv(ssq, r, fq); }
    __device__ __forceinline__ void row(int r, int pn, int wc, int fq, f32x4 v00, f32x4 v01, f32x4 v10, f32x4 v11, float rinv) const {
        const int col = 256 * pn + 32 * wc + 8 * fq;
        const f32x4 z = (f32x4){0.f, 0.f, 0.f, 0.f};
        v00 = __builtin_elementwise_max(v00 * rinv, z); v01 = __builtin_elementwise_max(v01 * rinv, z); v10 = __builtin_elementwise_max(v10 * rinv, z); v11 = __builtin_elementwise_max(v11 * rinv, z);
        __builtin_nontemporal_store(pack8(v00 * v00, v01 * v01), (u32x4*)(Mb + (size_t)r * DFF + col)); __builtin_nontemporal_store(pack8(v10 * v10, v11 * v11), (u32x4*)(Mb + (size_t)r * DFF + col + 128));
    }
};
template <class Row> struct EpiAdapt {
    static constexpr bool PERM = true, AFTER_DRAIN = false;
    Row R;
    __device__ __forceinline__ void operator()(const f32x4 (&acc)[2][2][4][2], const pg8::Unit& u, int wr, int wc, int fr, int fq) const {
        asm volatile("" ::: "memory");
#pragma unroll
        for (int ai = 0; ai < 2; ++ai)
#pragma unroll
            for (int m = 0; m < 4; ++m) { const int r = u.pm * 256 + ai * 128 + wr * 64 + m * 16 + fr; R.row(r, u.pn, wc, fq, acc[ai][0][m][0], acc[ai][0][m][1], acc[ai][1][m][0], acc[ai][1][m][1], R.prep(r, fq)); }
    }
};

template <class Row, int K>
__device__ __forceinline__ void skinny_unit(LAS unsigned char* lds, const bf16_t* A16, const bf16_t* Bt, int pn, int wc, const Row& R) {
    int tid = threadIdx.x; asm volatile("" : "+v"(tid));
    const int wid = __builtin_amdgcn_readfirstlane(tid >> 6), lane = tid & 63, fr = lane & 15, fq = lane >> 4;
    constexpr int KS = K / 8, NG = KS / 128;
    float rinv = 0.f; if (wid == 0) rinv = R.prep(MX + fr, fq);
    f32x4 acc[4];
#pragma unroll
    for (int t = 0; t < 4; ++t) acc[t] = (f32x4){0.f, 0.f, 0.f, 0.f};
    const bf16_t* ap = A16 + (size_t)fr * K + wid * KS + fq * 8;
    const bf16_t* bp = Bt + (size_t)(256 * pn + 32 * wc + 8 * (fr >> 2) + (fr & 3)) * K + wid * KS + fq * 8;
    bf16x8 af[1][4], bf[1][4][4];
#define SK_LOAD(buf, g) do { _Pragma("unroll") for (int st = 0; st < 4; ++st) { af[buf][st] = *(const bf16x8*)(ap + (g) * 128 + st * 32); \
        _Pragma("unroll") for (int t = 0; t < 4; ++t) bf[buf][st][t] = *(const bf16x8*)(bp + (size_t)(128 * (t >> 1) + 4 * (t & 1)) * K + (g) * 128 + st * 32); } } while (0)
    SK_LOAD(0, 0);
#pragma unroll
    for (int g = 0; g < NG; ++g) {
        if (g > 0) SK_LOAD(0, g);
#pragma unroll
        for (int st = 0; st < 4; ++st)
#pragma unroll
            for (int t = 0; t < 4; ++t) acc[t] = __builtin_amdgcn_mfma_f32_16x16x32_bf16(bf[0][st][t], af[0][st], acc[t], 0, 0, 0);
    }
#undef SK_LOAD
    LAS float* red = (LAS float*)lds;
#pragma unroll
    for (int t = 0; t < 4; ++t)
#pragma unroll
        for (int j = 0; j < 4; ++j) red[(wid * 16 + t * 4 + j) * 64 + lane] = acc[t][j];
    __syncthreads();
    if (wid == 0) {
        f32x4 v[4];
#pragma unroll
        for (int t = 0; t < 4; ++t)
#pragma unroll
            for (int j = 0; j < 4; ++j) { float sm = 0.f;
#pragma unroll
                for (int w = 0; w < 8; ++w) sm += red[(w * 16 + t * 4 + j) * 64 + lane];
                v[t][j] = sm; }
        R.row(MX + fr, pn, wc, fq, v[0], v[1], v[2], v[3], rinv);
    }
    __syncthreads();
}

__device__ __forceinline__ int glu_rowmap(int n0) { if (n0 < 512) return 256 * (n0 >> 7) + (n0 & 127); if (n0 < 1024) { const int n1 = n0 - 512; return 256 * (n1 >> 7) + 128 + (n1 & 127); } return n0; }
__device__ __forceinline__ int conv_job(LAS unsigned char* lds, int base, const float* src, int ldn, int K, int N, const float* gain, bf16_t* dst, int dst_ld, int koff, bool glu, int G = gridDim.x, int blk = blockIdx.x) {
    int tid = threadIdx.x; asm volatile("" : "+v"(tid));
    const int nT = N >> 6, nitems = (K >> 6) * nT;
    int first = (blk - base) % G; if (first < 0) first += G;
    const int kk0 = tid >> 4, n4 = (tid & 15) * 4;
    f32x4 x0 = (f32x4){0.f, 0.f, 0.f, 0.f}, x1 = x0, y0 = x0, y1 = x0;
#define CJ_LOAD(it_, x0, x1) do { const int kt_ = (it_) / nT, nt_ = (it_) - kt_ * nT; const float* s_ = src + (size_t)(kt_ * 64 + kk0) * ldn + nt_ * 64 + n4; \
        x0 = *(const f32x4*)s_; x1 = *(const f32x4*)(s_ + (size_t)32 * ldn); \
        if (gain) { x0 = x0 * gain[kt_ * 64 + kk0]; x1 = x1 * gain[kt_ * 64 + kk0 + 32]; } } while (0)
    if (first < nitems) CJ_LOAD(first, x0, x1);
    if (first + G < nitems) CJ_LOAD(first + G, y0, y1);
    int buf = 0;
    for (int it = first; it < nitems; it += G) {
        LAS float* tile = (LAS float*)lds + buf * (64 * 65);
        const int kt = it / nT, ntile = it - kt * nT, k0 = kt * 64, n0 = ntile * 64, drow0 = glu ? glu_rowmap(n0) : n0;
        tile[kk0 * 65 + n4 + 0] = x0[0]; tile[kk0 * 65 + n4 + 1] = x0[1]; tile[kk0 * 65 + n4 + 2] = x0[2]; tile[kk0 * 65 + n4 + 3] = x0[3];
        tile[(kk0 + 32) * 65 + n4 + 0] = x1[0]; tile[(kk0 + 32) * 65 + n4 + 1] = x1[1]; tile[(kk0 + 32) * 65 + n4 + 2] = x1[2]; tile[(kk0 + 32) * 65 + n4 + 3] = x1[3];
        x0 = y0; x1 = y1;
        if (it + 2 * G < nitems) CJ_LOAD(it + 2 * G, y0, y1);
        __syncthreads();
        { const int n = tid >> 3, kc = (tid & 7) * 8; u32x4 w;
          w.x = cvt_pk_bf16(tile[(kc + 0) * 65 + n], tile[(kc + 1) * 65 + n]); w.y = cvt_pk_bf16(tile[(kc + 2) * 65 + n], tile[(kc + 3) * 65 + n]);
          w.z = cvt_pk_bf16(tile[(kc + 4) * 65 + n], tile[(kc + 5) * 65 + n]); w.w = cvt_pk_bf16(tile[(kc + 6) * 65 + n], tile[(kc + 7) * 65 + n]);
          *(u32x4*)(dst + (size_t)(drow0 + n) * dst_ld + koff + k0 + kc) = w; }
        buf ^= 1;
    }
#undef CJ_LOAD
    __syncthreads();
    return base + nitems;
}

struct Params { const float* in[20]; float* out; unsigned char* ws; };
enum { I_X = 0, I_META, I_MIXG, I_MLPG, I_FING, I_EVWIN, I_CONVW, I_CONVB, I_LNG, I_LNB, I_POOLW, I_POOLB, I_POOLS, I_EVWOUT, I_ODWIN, I_GNORM, I_ODWOUT, I_LBP, I_W1, I_W2 };

__device__ __forceinline__ int seqrow(int b, int p) { return p < NMETA ? MX + p : b * SEQ + (p - NMETA); }

#define XB_TMO      128
#define XB_XCNT(j)  (256  + 64 * (j))
#define XB_XSUB(j)  (1280 + 64 * (j))
#define XB_XGEN(j)  (2304 + 64 * (j))
#define XB_TOP      3328
#define XB_TOPGEN   3392
#define XCD_BAR_WORDS 3456
#define XB_SPIN_CAP (1u << 18)

__device__ __forceinline__ unsigned xb_ld(unsigned* p)              { return __hip_atomic_load(p, __ATOMIC_RELAXED, __HIP_MEMORY_SCOPE_AGENT); }
__device__ __forceinline__ unsigned xb_add(unsigned* p, unsigned v) { return __hip_atomic_fetch_add(p, v, __ATOMIC_RELAXED, __HIP_MEMORY_SCOPE_AGENT); }
__device__ __forceinline__ unsigned xb_xcc_id() { return (unsigned)__builtin_amdgcn_s_getreg((3 << 11) | 20) & 0xFu; }
#define XB_SPIN(cond, bar) do { unsigned _sp = 0; while (cond) { __builtin_amdgcn_s_sleep(1); \
    if ((++_sp & 255u) == 0u) { if (xb_ld(&(bar)[XB_TMO])) break; if (_sp > XB_SPIN_CAP) { atomicAdd(&(bar)[XB_TMO], 1u); break; } } } } while (0)

struct XcdBarrier {
    unsigned* bar; unsigned x;
    volatile LAS unsigned* st;
};

__device__ __forceinline__ XcdBarrier xcd_barrier_post(unsigned* bar, volatile LAS unsigned* st) {
    XcdBarrier b; b.bar = bar; b.x = xb_xcc_id(); b.st = st;
    if (threadIdx.x == 0) (void)xb_add(&bar[XB_XCNT(b.x)], 1u);
    return b;
}
__device__ __forceinline__ void xcd_barrier_complete(unsigned* bar, unsigned x, unsigned& nloc, unsigned& nx) {
    const unsigned G = gridDim.x * gridDim.y * gridDim.z;
    unsigned sum, cnt, mine, sp = 0u;
    for (;;) {
        sum = 0u; cnt = 0u; mine = 0u;
#pragma unroll
        for (unsigned j = 0; j < 16; ++j) { const unsigned c = xb_ld(&bar[XB_XCNT(j)]); sum += c; cnt += (c > 0u) ? 1u : 0u; }
        mine = xb_ld(&bar[XB_XCNT(x)]);
        if (sum == G) break;
        __builtin_amdgcn_s_sleep(1);
        if ((++sp & 255u) == 0u) { if (xb_ld(&bar[XB_TMO])) break; if (sp > XB_SPIN_CAP) { atomicAdd(&bar[XB_TMO], 1u); break; } }
    }
    nloc = mine > 0u ? mine : 1u; nx = cnt > 0u ? cnt : 1u;
}

__device__ __forceinline__ void xcd_barrier(const XcdBarrier& b) {
    asm volatile("s_waitcnt vmcnt(0)" ::: "memory");
    __syncthreads();
    if (threadIdx.x == 0) {
        unsigned* bar = b.bar;
        __builtin_amdgcn_s_waitcnt(0);
        unsigned nloc = b.st[0], nx = b.st[1];
        if (nloc == 0u) { xcd_barrier_complete(bar, b.x, nloc, nx); b.st[0] = nloc; b.st[1] = nx; }
        const unsigned old = xb_add(&bar[XB_XSUB(b.x)], 1u);
        const unsigned gen = old / nloc;
        if (old + 1u == (gen + 1u) * nloc) {
            __builtin_amdgcn_fence(__ATOMIC_RELEASE, "agent");
            asm volatile("s_waitcnt vmcnt(0)" ::: "memory");
            const unsigned og = xb_add(&bar[XB_TOP], 1u);
            const unsigned tg = og / nx;
            if (og + 1u == (tg + 1u) * nx) xb_add(&bar[XB_TOPGEN], 1u);
            else XB_SPIN(xb_ld(&bar[XB_TOPGEN]) == tg, bar);
            __builtin_amdgcn_fence(__ATOMIC_ACQUIRE, "agent");
            xb_add(&bar[XB_XGEN(b.x)], 1u);
            asm volatile("s_waitcnt vmcnt(0)" ::: "memory");
        } else {
            XB_SPIN(xb_ld(&bar[XB_XGEN(b.x)]) == gen, bar);
            __builtin_amdgcn_fence(__ATOMIC_ACQUIRE, "agent");
            asm volatile("s_waitcnt vmcnt(0)" ::: "memory");
        }
    }
    __syncthreads();
}

#define PHASE_VARS \
    unsigned char* ws = p.ws; asm volatile("" : "+s"(ws)); \
    int tid = threadIdx.x; asm volatile("" : "+v"(tid)); \
    const int lane = tid & 63, wid = __builtin_amdgcn_readfirstlane(tid >> 6); \
    const float* const* IN = (const float* const*)(ws + WS_MISC + MISC_INPTR); (void)IN; \
    const int gw = bid * 8 + wid, gt = bid * 512 + tid; (void)gw; (void)gt; (void)lane; \
    bf16_t* WIN = (bf16_t*)(ws + WS_WIN); bf16_t* WOUT = (bf16_t*)(ws + WS_WOUT); bf16_t* W1 = (bf16_t*)(ws + WS_W1); bf16_t* W2 = (bf16_t*)(ws + WS_W2); \
    float* WTMP = (float*)(ws + WS_WTMP); \
    float* SSQ = (float*)(ws + WS_SSQ); float* LB = (float*)(ws + WS_MISC + MISC_LB); float* BIASC = (float*)(ws + WS_MISC + MISC_BIASC); float* BIASP = (float*)(ws + WS_MISC + MISC_BIASP); float* HMETA = (float*)(ws + WS_MISC + MISC_HMETA); (void)BIASP; \
    bf16_t* HB = (bf16_t*)(ws + WS_HB); bf16_t* UT = (bf16_t*)(ws + WS_UT); float* DL = (float*)(ws + WS_DL); (void)UT; (void)DL; \
    bf16_t* QB = (bf16_t*)(ws + WS_Q); bf16_t* VB = (bf16_t*)(ws + WS_V); bf16_t* SG = (bf16_t*)(ws + WS_SG); bf16_t* LOGF = (bf16_t*)(ws + WS_LOGF); bf16_t* YB = (bf16_t*)(ws + WS_Y); \
    bf16_t* AB = (bf16_t*)(ws + WS_A); bf16_t* PIN = (bf16_t*)(ws + WS_PIN); bf16_t* CAT = (bf16_t*)(ws + WS_CAT); bf16_t* MB = (bf16_t*)(ws + WS_M); \
    (void)WIN; (void)WOUT; (void)W1; (void)W2; (void)WTMP; (void)SSQ; (void)LB; (void)BIASC; (void)HMETA; (void)HB; (void)QB; (void)VB; (void)SG; (void)LOGF; (void)YB; (void)AB; (void)PIN; (void)CAT; (void)MB; \
    const int j = l >> 1; const bool odd = (l & 1) != 0; const int sb = G - 1 - bid; (void)j; (void)odd; (void)sb; \
    const float* ssq_mix = SSQ; float* ssq_mlp = SSQ; float* ssq_next = SSQ; (void)ssq_mix; (void)ssq_mlp; (void)ssq_next;


#ifndef PROBE_MLP
#define PROBE_MLP 0
#endif
#ifndef PROBE_MIX
#define PROBE_MIX 0
#endif
#define PASSC_ITEMS(wlo_, whi_) do { \
                for (int wi = (wlo_) + gw; wi < (whi_); wi += NGW) { \
                    int it, tp; if (wi < 4096) { it = wi >> 1; tp = wi & 1; } else { it = 2048 + (wi - 4096); tp = 1; } \
                    const int cidx = it >> 3, hc = (it & 7) * 128; const bool meta = (cidx == 256); \
                    const int lr0 = 32 * tp + fr, lr1 = lr0 + 16; \
                    const int gr0 = meta ? (lr0 >= 48 ? MX + lr0 - 48 : -1) : cidx * 64 + lr0, gr1 = meta ? (lr1 >= 48 ? MX + lr1 - 48 : -1) : cidx * 64 + lr1; \
                    f32x4 acc0[8], acc1[8]; \
                    _Pragma("unroll") for (int vb = 0; vb < 8; ++vb) { acc0[vb] = (f32x4){0.f, 0.f, 0.f, 0.f}; acc1[vb] = acc0[vb]; } \
                    if (!meta) { \
                        const bf16_t* sp = UT + (size_t)it * 16384 + (size_t)fr * 128 + 8 * fq; \
                        const bf16_t* qp0 = QB + (size_t)gr0 * 1024 + hc + 8 * fq; const bf16_t* qp1 = QB + (size_t)gr1 * 1024 + hc + 8 * fq; \
                        bf16x8 qf0[4], qf1[4]; \
                        _Pragma("unroll") for (int kk = 0; kk < 4; ++kk) { qf0[kk] = *(const bf16x8*)(qp0 + 32 * kk); qf1[kk] = *(const bf16x8*)(qp1 + 32 * kk); } \
                        _Pragma("unroll") for (int vb = 0; vb < 8; ++vb) { \
                            _Pragma("unroll") for (int kk = 0; kk < 4; ++kk) { const bf16x8 sf = *(const bf16x8*)(sp + vb * 16 * 128 + 32 * kk); \
                                acc0[vb] = __builtin_amdgcn_mfma_f32_16x16x32_bf16(sf, qf0[kk], acc0[vb], 0, 0, 0); acc1[vb] = __builtin_amdgcn_mfma_f32_16x16x32_bf16(sf, qf1[kk], acc1[vb], 0, 0, 0); } \
                            if (vb & 1) asm volatile("" ::: "memory"); } \
                    } \
                    _Pragma("unroll") for (int u = 0; u < 2; ++u) { const int gr = u ? gr1 : gr0; \
                        if (gr >= 0) { \
                            float ss = 0.f; f32x4 o[8]; \
                            _Pragma("unroll") for (int vb = 0; vb < 8; ++vb) { const u32x2 oi = *(const u32x2*)(VB + (size_t)gr * 1024 + hc + 16 * vb + 4 * fq); \
                                o[vb] = (u ? acc1[vb] : acc0[vb]) + (f32x4){bflo(oi.x), bfhi(oi.x), bflo(oi.y), bfhi(oi.y)}; const f32x4 q2 = o[vb] * o[vb]; ss += (q2[0] + q2[1]) + (q2[2] + q2[3]); } \
                            ss += __shfl_xor(ss, 16); ss += __shfl_xor(ss, 32); \
                            const float rn = rsqrtf(ss * (1.0f / 128.0f) + EPS); \
                            _Pragma("unroll") for (int vb = 0; vb < 8; ++vb) { const int col = 16 * vb + 4 * fq; const u32x2 sg = *(const u32x2*)(SG + (size_t)gr * 1024 + hc + col); \
                                const f32x4 y = o[vb] * rn * *(const f32x4*)(gg + col) * (f32x4){bflo(sg.x), bfhi(sg.x), bflo(sg.y), bfhi(sg.y)}; \
                                u32x2 w; w.x = cvt_pk_bf16(y[0], y[1]); w.y = cvt_pk_bf16(y[2], y[3]); *(u32x2*)(YB + (size_t)gr * 1024 + hc + col) = w; } } } \
                } \
} while (0)
__global__ void __launch_bounds__(512, 2) fwd(Params p) {
    extern __shared__ __attribute__((aligned(16))) unsigned char lds_raw[];
    cg::grid_group grid = cg::this_grid();
    LAS unsigned char* lds = (LAS unsigned char*)lds_raw;
    const int bid = blockIdx.x, G = gridDim.x, NGW = G * 8, NGT = G * 512;
    volatile LAS unsigned* bar_st = (volatile LAS unsigned*)(lds + LDS_BYTES - 16);
    if (threadIdx.x < 4) bar_st[threadIdx.x] = 0u;
    if (bid == 0) {
        if (threadIdx.x == 0) { const float** tb = (const float**)(p.ws + WS_MISC + MISC_INPTR);
#pragma unroll
            for (int i = 0; i < 20; ++i) tb[i] = p.in[i];
            tb[20] = p.out; } }
    __syncthreads();
    const XcdBarrier xbar = xcd_barrier_post((unsigned*)(p.ws + WS_MISC + MISC_BAR), bar_st);
#define GRID_BAR() xcd_barrier(xbar)
    {
        const int l = 0; PHASE_VARS
        for (int r = gw; r < MR; r += NGW) {
            const float* src = (r < MX) ? p.in[I_X] + (size_t)r * D : p.in[I_META] + (size_t)(r - MX) * D;
            float s = 0.f;
#pragma unroll
            for (int i = 0; i < 4; ++i) { const int c = lane * 4 + 256 * i; const f32x4 v = __builtin_nontemporal_load((const f32x4*)(src + c));
                u32x2 w; w.x = cvt_pk_bf16(v[0], v[1]); w.y = cvt_pk_bf16(v[2], v[3]); *(u32x2*)(HB + (size_t)r * D + c) = w;
                s += (v[0] * v[0] + v[1] * v[1]) + (v[2] * v[2] + v[3] * v[3]); }
            s = wave_sum(s); if (lane < 16) SSQ[(size_t)lane * MR + r] = (lane == 0) ? s : 0.f;
        }
        if (gt < 1024) {
            const float* lp = p.in[I_LBP]; const float a0 = lp[gt], a1 = lp[1024 + gt], a2 = lp[2048 + gt], a3 = lp[3072 + gt];
            const float mx = fmaxf(fmaxf(a0, a1), fmaxf(a2, a3)); const float e0 = expf(a0 - mx), e1 = expf(a1 - mx), e2 = expf(a2 - mx), e3 = expf(a3 - mx); const float inv = 1.0f / (e0 + e1 + e2 + e3);
            LB[gt] = e1 * inv; LB[1024 + gt] = (e1 + e2 + e3) * inv;
        }
        conv_job(lds, 0, p.in[I_EVWIN], 1536, 1024, 1536, p.in[I_MIXG], WIN, 1024, 0, true);
    }
    GRID_BAR();
    if (p.ws == nullptr) grid.sync();

    for (int l = 0; l < 4; ++l) {
        if ((l & 1) == 0) {
            PHASE_VARS
            {
                const int fr = lane & 15, fq = lane >> 4;
                for (int tile = gw; tile < 4 * 9 * 64; tile += NGW) {
                    const int g = tile / 576, rem = tile - g * 576, ct = rem >> 6, nt = rem & 63;
                    const float* pw = (ct < 8) ? IN[I_POOLW] + ((size_t)(j * 4 + g) * 128 + 16 * ct + fr) * 128 : IN[I_POOLB] + (size_t)(j * 4 + g) * 128;
                    const bool live = (ct < 8) || (fr == 0);
                    const float* sc = IN[I_POOLS] + j * 512 + g * 128;
                    const float* wo = IN[I_EVWOUT] + ((size_t)j * 1024 + 512 + g * 128) * 1024 + 16 * nt + fr;
                    f32x4 acc = (f32x4){0.f, 0.f, 0.f, 0.f};
#pragma unroll
                    for (int kk = 0; kk < 4; ++kk) { const int d0 = 32 * kk + 8 * fq;
                        f32x4 a0 = *(const f32x4*)(pw + d0) * *(const f32x4*)(sc + d0), a1 = *(const f32x4*)(pw + d0 + 4) * *(const f32x4*)(sc + d0 + 4);
                        if (!live) { a0 = (f32x4){0.f, 0.f, 0.f, 0.f}; a1 = a0; }
                        f32x4 b0, b1;
#pragma unroll
                        for (int e = 0; e < 4; ++e) { b0[e] = wo[(size_t)(d0 + e) * 1024]; b1[e] = wo[(size_t)(d0 + 4 + e) * 1024]; }
                        acc = __builtin_amdgcn_mfma_f32_16x16x32_bf16(mk8(a0, a1), mk8(b0, b1), acc, 0, 0, 0); }
                    if (ct < 8) {
#pragma unroll
                        for (int jj = 0; jj < 4; ++jj) WTMP[(size_t)(g * 128 + 16 * ct + 4 * fq + jj) * 1024 + 16 * nt + fr] = acc[jj];
                    } else if (fq == 0) BIASP[g * 1024 + 16 * nt + fr] = acc[0];
                }
            }
            RowEvenIn R{AB, PIN, ssq_mix};
            if (sb < 1536 / 64) skinny_unit<decltype(R), 1024>(lds, HB + (size_t)MX * D, WIN, sb >> 2, sb & 3, R);
            pg8::Gemm g{HB, WIN, MX, 1536, 1024}; pg8::StaticOrder S; S.init(MX, 1536, G, bid); EpiAdapt<RowEvenIn> E{R};
            pg8::gemm_phase<EpiAdapt<RowEvenIn>, pg8::StaticOrder, true, true>(lds, g, S, E);
            if (G == 256 && bid >= 128) {
                int base = 0;
                base = conv_job(lds, base, IN[I_W1] + (size_t)l * 1024 * 4096, 4096, 1024, 4096, IN[I_MLPG] + l * 1024, W1, 1024, 0, false, 128, bid - 128);
                base = conv_job(lds, base, IN[I_W2] + (size_t)l * 4096 * 1024, 1024, 4096, 1024, nullptr, W2, 4096, 0, false, 128, bid - 128);
            }
        } else {
            PHASE_VARS
            if ((bid & 1) == 0) conv_job(lds, 0, IN[I_W2] + (size_t)l * 4096 * 1024, 1024, 4096, 1024, nullptr, W2, 4096, 0, false);
            RowOddIn R{QB, LOGF, VB, SG, ssq_mix, LB + j * 1024};
            if (sb < 4096 / 64) skinny_unit<decltype(R), 1024>(lds, HB + (size_t)MX * D, WIN, sb >> 2, sb & 3, R);
            pg8::Gemm g{HB, WIN, MX, 4096, 1024}; pg8::StaticOrder S; S.init(MX, 4096, G, bid); EpiAdapt<RowOddIn> E{R};
            pg8::gemm_phase<EpiAdapt<RowOddIn>, pg8::StaticOrder, true, true>(lds, g, S, E);
            if ((bid & 1) != 0) conv_job(lds, 0, IN[I_W2] + (size_t)l * 4096 * 1024, 1024, 4096, 1024, nullptr, W2, 4096, 0, false);
        }
        GRID_BAR();
        {
            PHASE_VARS
            if (!odd && gt < 1024) BIASC[gt] = (BIASP[gt] + BIASP[1024 + gt]) + (BIASP[2048 + gt] + BIASP[3072 + gt]);
            const int skipb = (G == 256 && odd) ? 8 : 0, Gc = G - skipb, bc = bid - skipb;
            if (bc >= 0) {
            int base = 0;
            if (!odd) { base = conv_job(lds, base, IN[I_EVWOUT] + (size_t)j * 1024 * 1024, 1024, 512, 1024, nullptr, WOUT, 1024, 0, false, Gc, bc);
                        base = conv_job(lds, base, WTMP, 1024, 512, 1024, nullptr, WOUT, 1024, 512, false, Gc, bc);
                        }
            else base = conv_job(lds, base, IN[I_ODWOUT] + (size_t)j * 1024 * 1024, 1024, 1024, 1024, nullptr, WOUT, 1024, 0, false, Gc, bc);
            if (odd || G != 256) base = conv_job(lds, base, IN[I_W1] + (size_t)l * 1024 * 4096, 4096, 1024, 4096, IN[I_MLPG] + l * 1024, W1, 1024, 0, false, Gc, bc);
            if (!odd && G != 256) base = conv_job(lds, base, IN[I_W2] + (size_t)l * 4096 * 1024, 1024, 4096, 1024, nullptr, W2, 4096, 0, false, Gc, bc);
            }
        }
        if ((l & 1) == 0) {
            PHASE_VARS
            LAS unsigned char* TA = lds;
            LAS unsigned char* TW = lds + 96256;
            { const float* cwg = IN[I_CONVW] + (size_t)j * 31 * 512;
              for (int ch = wid; ch < 62; ch += 8) { const int tap = ch >> 1, half = ch & 1;
                  __builtin_amdgcn_global_load_lds((const unsigned*)(cwg + tap * 512 + lane * 8 + half * 4), (LAS unsigned*)(TW + ch * 1024), 16, 0, 0); } }
            for (int bi = bid; bi < 256; bi += G) {
                const int b = bi >> 6, tb0 = NMETA + ((bi & 63) << 6); const bool extra = (bi == 0);
                for (int r = wid; r < 94; r += 8) { const int pp = tb0 - 30 + r;
                    if (pp >= 0) __builtin_amdgcn_global_load_lds((const unsigned*)(AB + (size_t)seqrow(b, pp) * 512 + lane * 8), (LAS unsigned*)(TA + r * 1024), 16, 0, 0);
                    else *(LAS u32x4*)(TA + r * 1024 + lane * 16) = (u32x4){0u, 0u, 0u, 0u}; }
                asm volatile("s_waitcnt vmcnt(0) lgkmcnt(0)" ::: "memory"); __syncthreads();
                for (int op = 0; op < ((extra && wid < 2) ? 2 : 1); ++op) {
                    const int t0 = (op == 0) ? tb0 + 8 * wid : 8 * wid, rb = t0 - tb0;
                    const int c0 = lane * 8;
                    f32x4 ya0[4], ya1[4], yb0[4], yb1[4], w0[4], w1[4];
                    { const f32x4 cb0 = *(const f32x4*)(IN[I_CONVB] + j * 512 + c0), cb1 = *(const f32x4*)(IN[I_CONVB] + j * 512 + c0 + 4);
#pragma unroll
                      for (int o = 0; o < 4; ++o) { ya0[o] = cb0; ya1[o] = cb1; yb0[o] = cb0; yb1[o] = cb1; w0[o] = (f32x4){0.f, 0.f, 0.f, 0.f}; w1[o] = w0[o]; } }
#pragma unroll 1
                    for (int i0 = 0; i0 < 36; i0 += 4) {
#pragma unroll
                        for (int ii = 0; ii < 4; ++ii) {
                            const int i = i0 + ii;
                            f32x4 t0_ = (f32x4){0.f, 0.f, 0.f, 0.f}, t1_ = t0_;
                            if (i <= 30) { t0_ = *(LAS f32x4*)(TW + (2 * i) * 1024 + lane * 16); t1_ = *(LAS f32x4*)(TW + (2 * i + 1) * 1024 + lane * 16); }
                            w0[ii] = t0_; w1[ii] = t1_;
                            f32x4 a0 = (f32x4){0.f, 0.f, 0.f, 0.f}, a1 = a0, b0 = a0, b1 = a0;
                            if (i < 34 && rb + i >= 0) { const u32x4 av = *(LAS u32x4*)(TA + (rb + i) * 1024 + lane * 16);
                                a0 = (f32x4){bflo(av.x), bfhi(av.x), bflo(av.y), bfhi(av.y)}; a1 = (f32x4){bflo(av.z), bfhi(av.z), bflo(av.w), bfhi(av.w)}; }
                            if (i < 34 && rb + 4 + i >= 0) { const u32x4 bv = *(LAS u32x4*)(TA + (rb + 4 + i) * 1024 + lane * 16);
                                b0 = (f32x4){bflo(bv.x), bfhi(bv.x), bflo(bv.y), bfhi(bv.y)}; b1 = (f32x4){bflo(bv.z), bfhi(bv.z), bflo(bv.w), bfhi(bv.w)}; }
#pragma unroll
                            for (int o = 0; o < 4; ++o) { ya0[o] += w0[(ii - o) & 3] * a0; ya1[o] += w1[(ii - o) & 3] * a1; yb0[o] += w0[(ii - o) & 3] * b0; yb1[o] += w1[(ii - o) & 3] * b1; }
                        }
                    }
                    const float* lg = IN[I_LNG] + j * 512 + c0; const float* lbp = IN[I_LNB] + j * 512 + c0;
                    const f32x4 g0 = *(const f32x4*)lg, g1 = *(const f32x4*)(lg + 4), bb0 = *(const f32x4*)lbp, bb1 = *(const f32x4*)(lbp + 4);
#pragma unroll
                    for (int o = 0; o < 8; ++o) {
                        const int r = seqrow(b, t0 + o);
                        const f32x4 y0 = (o < 4) ? ya0[o & 3] : yb0[o & 3], y1 = (o < 4) ? ya1[o & 3] : yb1[o & 3];
                        const float s_ = ((y0[0] + y0[1]) + (y0[2] + y0[3])) + ((y1[0] + y1[1]) + (y1[2] + y1[3]));
                        const float mu = wave_sum(s_) * (1.0f / 512.0f);
                        const f32x4 d0 = y0 - mu, d1 = y1 - mu; const f32x4 qq = d0 * d0 + d1 * d1;
                        const float var = wave_sum((qq[0] + qq[1]) + (qq[2] + qq[3])) * (1.0f / 512.0f);
                        const float rs = rsqrtf(var + EPS);
                        f32x4 z0 = d0 * rs * g0 + bb0, z1 = d1 * rs * g1 + bb1;
                        z0 = z0 * sigm4(z0); z1 = z1 * sigm4(z1);
                        *(u32x4*)(CAT + (size_t)r * 1024 + c0) = pack8(z0, z1);
                    }
                }
                __syncthreads();
                for (int r = wid; r < 80; r += 8) { const int pp = tb0 - 16 + r;
                    __builtin_amdgcn_global_load_lds((const unsigned*)(PIN + (size_t)seqrow(b, pp) * 512 + lane * 8), (LAS unsigned*)(TA + r * 1024), 16, 0, 0); }
                asm volatile("s_waitcnt vmcnt(0) lgkmcnt(0)" ::: "memory"); __syncthreads();
                for (int wi = wid; wi < (extra ? 40 : 32); wi += 8) {
                    const int q = wi >> 2, g = wi & 3, pw = 2 << g, c = g * 128 + 2 * lane;
                    const int t0 = (q < 8) ? tb0 + 8 * q : 8 * (q - 8), rb = t0 - tb0 + 1;
                    f32x2 pv[23];
#pragma unroll
                    for (int i = 0; i < 23; ++i) { pv[i] = (f32x2){0.f, 0.f};
                        if (i >= 16 - pw && rb + i >= 0) { const unsigned w = *(LAS unsigned*)(TA + (rb + i) * 1024 + g * 256 + lane * 4); pv[i] = (f32x2){bflo(w), bfhi(w)}; } }
#pragma unroll
                    for (int o = 0; o < 8; ++o) { f32x2 sm = (f32x2){0.f, 0.f};
#pragma unroll
                        for (int ii = 0; ii < 16; ++ii) if (ii < pw) sm += pv[15 + o - ii];
                        const int t = t0 + o; const float inv = 1.0f / (float)((t + 1 < pw) ? (t + 1) : pw);
                        const f32x2 d = sm * inv - pv[15 + o];
                        *(unsigned*)(CAT + (size_t)seqrow(b, t) * 1024 + 512 + c) = cvt_pk_bf16(d[0], d[1]); }
                }
                __syncthreads();
            }
        } else {
            PHASE_VARS
            LAS float* Lb = (LAS float*)lds;
            LAS bf16_t* Lkb = (LAS bf16_t*)(lds + 33792);
            LAS bf16_t* Lq = (LAS bf16_t*)(lds + 51200);
            LAS bf16_t* LvT = (LAS bf16_t*)(lds + 68608);
            LAS float* Lraw = (LAS float*)(lds + 87040);
            LAS bf16_t* LP = (LAS bf16_t*)(lds + 87040);
            LAS bf16_t* LKdT = (LAS bf16_t*)(lds + 120832);
            const int fr = lane & 15, fq = lane >> 4;
            u32x4 pl[2], pq[2], pvv[2];
#define PA_ROW(lr_) (meta_ ? ((lr_) >= 48 ? MX + (lr_) - 48 : -1) : cidx_ * 64 + (lr_))
#define PA_ISSUE_L(it_, tid) do { const int cidx_ = (it_) >> 3, hc_ = ((it_) & 7) * 128; const bool meta_ = (cidx_ == 256); \
                _Pragma("unroll") for (int i = 0; i < 2; ++i) { const int e = tid + 512 * i, lr = e >> 4, c8 = (e & 15) * 8; const int gr = PA_ROW(lr); \
                    pl[i] = (u32x4){0u, 0u, 0u, 0u}; if (gr >= 0) pl[i] = *(const u32x4*)(LOGF + (size_t)gr * 1024 + hc_ + c8); } } while (0)
#define PA_ISSUE_QV(it_, tid) do { const int cidx_ = (it_) >> 3, hc_ = ((it_) & 7) * 128; const bool meta_ = (cidx_ == 256); \
                _Pragma("unroll") for (int i = 0; i < 2; ++i) { const int e = tid + 512 * i; \
                    { const int lr = e >> 4, c8 = (e & 15) * 8; const int gr = PA_ROW(lr); pq[i] = (u32x4){0u, 0u, 0u, 0u}; if (gr >= 0) pq[i] = *(const u32x4*)(QB + (size_t)gr * 1024 + hc_ + c8); } \
                    { const int lr = e & 63, c8 = (e >> 6) * 8; const int gr = PA_ROW(lr); pvv[i] = (u32x4){0u, 0u, 0u, 0u}; if (gr >= 0) pvv[i] = *(const u32x4*)(VB + (size_t)gr * 1024 + hc_ + c8); } } } while (0)
            if (bid < NCH) PA_ISSUE_L(bid, tid);
            for (int it = bid; it < NCH; it += G) {
                int tl = tid; asm volatile("" : "+v"(tl));
                const int lanel = tl & 63, frl = lanel & 15, fql = lanel >> 4, widl = __builtin_amdgcn_readfirstlane(tl >> 6);
                PA_ISSUE_QV(it, tl);
                const int cidx = it >> 3, hc = (it & 7) * 128; const bool meta = (cidx == 256);
#pragma unroll
                for (int i = 0; i < 2; ++i) { const int e = tl + 512 * i, lr = e >> 4, c8 = (e & 15) * 8; const u32x4 lw = pl[i];
                    *(LAS f32x4*)(Lraw + lr * 132 + c8) = (f32x4){bflo(lw.x), bfhi(lw.x), bflo(lw.y), bfhi(lw.y)}; *(LAS f32x4*)(Lraw + lr * 132 + c8 + 4) = (f32x4){bflo(lw.z), bfhi(lw.z), bflo(lw.w), bfhi(lw.w)}; }
                __syncthreads();
                if (it + G < NCH) PA_ISSUE_L(it + G, tl);
                { const int col = tl & 127, sc = tl >> 7; float pre = 0.f, tot = 0.f;
#pragma unroll 4
                  for (int r = 0; r < 64; ++r) { const float x = Lraw[r * 132 + col]; tot += x; if (r < 16 * sc) pre = tot; }
                  float run = pre;
#pragma unroll
                  for (int r = 0; r < 16; ++r) { const int row = 16 * sc + r; const float lf = Lraw[row * 132 + col]; run += lf; Lb[row * 132 + col] = run;
                      const float kf = 1.0f - __expf(lf); Lkb[row * 136 + col] = f2bf(kf); LKdT[col * 72 + row] = f2bf(kf * __expf(tot - run)); }
                  if (sc == 3) DL[(size_t)it * 128 + col] = __expf(tot); }
#pragma unroll
                for (int i = 0; i < 2; ++i) { const int e = tl + 512 * i;
                    { const int lr = e >> 4, c8 = (e & 15) * 8; *(LAS u32x4*)(Lq + lr * 136 + c8) = pq[i]; }
                    { const int lr = e & 63, c8 = (e >> 6) * 8; const u32x4 vv = pvv[i];
                      LvT[(c8 + 0) * 72 + lr] = (bf16_t)(vv.x & 0xffffu); LvT[(c8 + 1) * 72 + lr] = (bf16_t)(vv.x >> 16); LvT[(c8 + 2) * 72 + lr] = (bf16_t)(vv.y & 0xffffu); LvT[(c8 + 3) * 72 + lr] = (bf16_t)(vv.y >> 16);
                      LvT[(c8 + 4) * 72 + lr] = (bf16_t)(vv.z & 0xffffu); LvT[(c8 + 5) * 72 + lr] = (bf16_t)(vv.z >> 16); LvT[(c8 + 6) * 72 + lr] = (bf16_t)(vv.w & 0xffffu); LvT[(c8 + 7) * 72 + lr] = (bf16_t)(vv.w >> 16); } }
                __syncthreads();
#pragma unroll
                for (int i = 0; i < 2; ++i) { const int e = tl + 512 * i, lr = e >> 4, c8 = (e & 15) * 8; const int gr = meta ? (lr >= 48 ? MX + lr - 48 : -1) : cidx * 64 + lr;
                    if (gr >= 0) { const u32x4 qv = *(LAS u32x4*)(Lq + lr * 136 + c8); const f32x4 e0 = exp4(*(LAS f32x4*)(Lb + lr * 132 + c8)), e1 = exp4(*(LAS f32x4*)(Lb + lr * 132 + c8 + 4));
                        const f32x4 a0 = (f32x4){bflo(qv.x), bfhi(qv.x), bflo(qv.y), bfhi(qv.y)} * e0, a1 = (f32x4){bflo(qv.z), bfhi(qv.z), bflo(qv.w), bfhi(qv.w)} * e1;
                        *(u32x4*)(QB + (size_t)gr * 1024 + hc + c8) = pack8(a0, a1); } }
                for (int idx = widl; idx < 10; idx += 8) {
                    const int i = idx >= 6 ? 3 : (idx >= 3 ? 2 : (idx >= 1 ? 1 : 0)), jb = idx - (i * (i + 1)) / 2;
                    const int t = 16 * i + frl, s_ = 16 * jb + frl;
                    f32x4 acc = (f32x4){0.f, 0.f, 0.f, 0.f};
#pragma unroll 1
                    for (int kk = 0; kk < 4; ++kk) { const int c = 32 * kk + 8 * fql;
                        f32x4 B0 = (f32x4){0.f, 0.f, 0.f, 0.f}, B1 = B0; if (i > 0) { B0 = *(LAS f32x4*)(Lb + (16 * i - 1) * 132 + c); B1 = *(LAS f32x4*)(Lb + (16 * i - 1) * 132 + c + 4); }
                        const f32x4 bt0 = *(LAS f32x4*)(Lb + t * 132 + c), bt1 = *(LAS f32x4*)(Lb + t * 132 + c + 4), bs0 = *(LAS f32x4*)(Lb + s_ * 132 + c), bs1 = *(LAS f32x4*)(Lb + s_ * 132 + c + 4);
                        const u32x4 qv = *(LAS u32x4*)(Lq + t * 136 + c), kv = *(LAS u32x4*)(Lkb + s_ * 136 + c);
                        const f32x4 m80 = (f32x4){80.f, 80.f, 80.f, 80.f};
                        const f32x4 qa0 = (f32x4){bflo(qv.x), bfhi(qv.x), bflo(qv.y), bfhi(qv.y)} * exp4(bt0 - B0), qa1 = (f32x4){bflo(qv.z), bfhi(qv.z), bflo(qv.w), bfhi(qv.w)} * exp4(bt1 - B1);
                        const f32x4 ka0 = (f32x4){bflo(kv.x), bfhi(kv.x), bflo(kv.y), bfhi(kv.y)} * exp4(__builtin_elementwise_min(B0 - bs0, m80)), ka1 = (f32x4){bflo(kv.z), bfhi(kv.z), bflo(kv.w), bfhi(kv.w)} * exp4(__builtin_elementwise_min(B1 - bs1, m80));
                        acc = __builtin_amdgcn_mfma_f32_16x16x32_bf16(mk8(ka0, ka1), mk8(qa0, qa1), acc, 0, 0, 0); }
                    if (i == jb) {
#pragma unroll
                        for (int jj = 0; jj < 4; ++jj) if (4 * fql + jj > frl) acc[jj] = 0.f; }
                    u32x2 w; w.x = cvt_pk_bf16(acc[0], acc[1]); w.y = cvt_pk_bf16(acc[2], acc[3]);
                    *(LAS u32x2*)(LP + t * 72 + 16 * jb + 4 * fql) = w;
                }
                if (widl >= 2) { const int u = widl - 2, i = u < 3 ? 0 : (u < 5 ? 1 : 2), jb = u < 3 ? u + 1 : (u < 5 ? u - 1 : 3);
                    *(LAS u32x2*)(LP + (16 * i + frl) * 72 + 16 * jb + 4 * fql) = (u32x2){0u, 0u}; }
                __syncthreads();
                {
#pragma unroll
                    for (int i = 0; i < 4; ++i) {
                        f32x4 acc = (f32x4){0.f, 0.f, 0.f, 0.f};
#pragma unroll
                        for (int ss = 0; ss < 2; ++ss) if (ss == 0 || i >= 2) {
                            const bf16x8 a = *(LAS bf16x8*)(LvT + (16 * widl + frl) * 72 + 32 * ss + 8 * fql), bb = *(LAS bf16x8*)(LP + (16 * i + frl) * 72 + 32 * ss + 8 * fql);
                            acc = __builtin_amdgcn_mfma_f32_16x16x32_bf16(a, bb, acc, 0, 0, 0); }
                        const int lr = 16 * i + frl; const int gr = meta ? (lr >= 48 ? MX + lr - 48 : -1) : cidx * 64 + lr;
                        if (gr >= 0) { u32x2 w; w.x = cvt_pk_bf16(acc[0], acc[1]); w.y = cvt_pk_bf16(acc[2], acc[3]); *(u32x2*)(VB + (size_t)gr * 1024 + hc + 16 * widl + 4 * fql) = w; }
                    }
                    bf16_t* ut = UT + (size_t)it * 16384;
                    const bf16x8 v0 = *(LAS bf16x8*)(LvT + (16 * widl + frl) * 72 + 8 * fql), v1 = *(LAS bf16x8*)(LvT + (16 * widl + frl) * 72 + 32 + 8 * fql);
#pragma unroll
                    for (int kb = 0; kb < 8; ++kb) {
                        const bf16x8 a0 = *(LAS bf16x8*)(LKdT + (16 * kb + frl) * 72 + 8 * fql), a1 = *(LAS bf16x8*)(LKdT + (16 * kb + frl) * 72 + 32 + 8 * fql);
                        f32x4 acc = (f32x4){0.f, 0.f, 0.f, 0.f};
                        acc = __builtin_amdgcn_mfma_f32_16x16x32_bf16(a0, v0, acc, 0, 0, 0); acc = __builtin_amdgcn_mfma_f32_16x16x32_bf16(a1, v1, acc, 0, 0, 0);
                        u32x2 w; w.x = cvt_pk_bf16(acc[0], acc[1]); w.y = cvt_pk_bf16(acc[2], acc[3]);
                        *(u32x2*)(ut + (16 * widl + frl) * 128 + 16 * kb + 4 * fql) = w;
                    }
                }
                __syncthreads();
            }
#undef PA_ISSUE_L
#undef PA_ISSUE_QV
#undef PA_ROW
        }
        GRID_BAR();
        if (l & 1) {
            {
                PHASE_VARS
                for (int rep = 0; rep < 1 + ((PROBE_MIX >> 3) & 1); ++rep) {
                const bool dry = (rep < ((PROBE_MIX >> 3) & 1)) && (((size_t)p.ws & 1) == 0);
                for (int g2 = gt; g2 < 32 * 4096; g2 += NGT) {
                    const int e4 = g2 & 4095, bh = g2 >> 12, b = bh >> 3, h = bh & 7, k4 = (e4 & 31) * 4;
                    const u32x2 m0 = *(const u32x2*)(UT + (size_t)(2048 + h) * 16384 + e4 * 4);
                    f32x4 S = (f32x4){bflo(m0.x), bfhi(m0.x), bflo(m0.y), bfhi(m0.y)};
                    for (int n0 = 0; n0 < 64; n0 += 16) {
                        u32x2 U[16]; f32x4 d[16];
#pragma unroll
                        for (int u = 0; u < 16; ++u) { const size_t item = (size_t)((b * 64 + n0 + u) * 8 + h); U[u] = *(const u32x2*)(UT + item * 16384 + e4 * 4); d[u] = *(const f32x4*)(DL + item * 128 + k4); }
#pragma unroll
                        for (int u = 0; u < 16; ++u) { const size_t item = (size_t)((b * 64 + n0 + u) * 8 + h);
                            u32x2 w; w.x = cvt_pk_bf16(S[0], S[1]); w.y = cvt_pk_bf16(S[2], S[3]); if (dry) w = U[u]; *(u32x2*)(UT + item * 16384 + e4 * 4) = w;
                            S = d[u] * S + (f32x4){bflo(U[u].x), bfhi(U[u].x), bflo(U[u].y), bfhi(U[u].y)}; }
                    }
                }
                }
            }
            GRID_BAR();
            {
                PHASE_VARS
                const int fr = lane & 15, fq = lane >> 4;
                const float* gg = IN[I_GNORM] + j * 128;
                PASSC_ITEMS(0, 4104);
            }
            GRID_BAR();
        }
        {
            PHASE_VARS
            const bf16_t* A = odd ? YB : CAT;
            RowRes R{HB, ssq_mlp, odd ? nullptr : BIASC, 1.0f};
            if (sb < 1024 / 64) skinny_unit<decltype(R), 1024>(lds, A + (size_t)MX * D, WOUT, sb >> 2, sb & 3, R);
            pg8::Gemm g{A, WOUT, MX, 1024, 1024}; pg8::StaticOrder S; S.init(MX, 1024, G, bid); EpiAdapt<RowRes> E{R};
            pg8::gemm_phase<EpiAdapt<RowRes>, pg8::StaticOrder, true, true>(lds, g, S, E);
        }
        GRID_BAR();
        for (int rep = 0; rep < 1 + PROBE_MLP; ++rep) {
            PHASE_VARS
#define G3_CONV() do { int base = 0; \
                if (l < 3) { if (!odd) base = conv_job(lds, base, IN[I_ODWIN] + (size_t)j * 1024 * 4096, 4096, 1024, 4096, IN[I_MIXG] + (l + 1) * 1024, WIN, 1024, 0, false); \
                             else base = conv_job(lds, base, IN[I_EVWIN] + (size_t)(j + 1) * 1024 * 1536, 1536, 1024, 1536, IN[I_MIXG] + (l + 1) * 1024, WIN, 1024, 0, true); } } while (0)
            if (rep == 0 && (bid & 1) == 0) G3_CONV();
            RowMlpUp R{MB, ssq_mlp};
            if (sb < 4096 / 64) skinny_unit<decltype(R), 1024>(lds, HB + (size_t)MX * D, W1, sb >> 2, sb & 3, R);
            pg8::Gemm g{HB, W1, MX, 4096, 1024}; pg8::StaticOrder S; S.init(MX, 4096, G, bid); EpiAdapt<RowMlpUp> E{R};
            pg8::gemm_phase<EpiAdapt<RowMlpUp>, pg8::StaticOrder, true, true>(lds, g, S, E);
            if (rep == 0 && (bid & 1) != 0) G3_CONV();
#undef G3_CONV
            if (rep < PROBE_MLP) GRID_BAR();
        }
        GRID_BAR();
        for (int rep = 0; rep < 1 + PROBE_MLP; ++rep) {
            PHASE_VARS
            const float gain = (rep < PROBE_MLP) ? (((size_t)p.ws & 1) ? 1.0f : 0.0f) : 1.0f;
            RowRes R{HB, ssq_next, nullptr, gain};
            if (sb < 1024 / 64) skinny_unit<decltype(R), 4096>(lds, MB + (size_t)MX * DFF, W2, sb >> 2, sb & 3, R);
            pg8::Gemm g{MB, W2, MX, 1024, 4096}; pg8::StaticOrder S; S.init(MX, 1024, G, bid); EpiAdapt<RowRes> E{R};
            pg8::gemm_phase<EpiAdapt<RowRes>, pg8::StaticOrder, true, true>(lds, g, S, E);
            if (rep < PROBE_MLP) GRID_BAR();
        }
        GRID_BAR();
    }
    {
        const int l = 0; PHASE_VARS
        const float* fg = IN[I_FING];
        for (int r = gw; r < MX; r += NGW) {
            const float part = (lane < 16) ? SSQ[(size_t)lane * MR + r] : 0.f;
            float s4 = part; s4 += __shfl_xor(s4, 1); s4 += __shfl_xor(s4, 2);
            s4 += __shfl_xor(s4, 4); s4 += __shfl_xor(s4, 8);
            const float tot = __shfl(s4, 0);
            const float rinv = rsqrtf(tot * (1.0f / D) + EPS);
#pragma unroll
            for (int i = 0; i < 4; ++i) { const int c = lane * 4 + 256 * i; const u32x2 hw = *(const u32x2*)(HB + (size_t)r * D + c); f32x4 v = (f32x4){bflo(hw.x), bfhi(hw.x), bflo(hw.y), bfhi(hw.y)}; v = v * rinv * *(const f32x4*)(fg + c); __builtin_nontemporal_store(v, (f32x4*)(((float*)IN[20]) + (size_t)r * D + c)); }
        }
    }
}

extern "C" void kernel_launch(void* const* d_in, const int* in_sizes, int n_in, void* d_out, int out_size, void* d_ws, size_t ws_size, hipStream_t stream) {
    static int grid = 0;
    if (grid == 0) {
        int dev = 0, cus = 0, per_cu = 0;
        if (n_in != 20 || ws_size < WS_END) { fprintf(stderr, "kernel_launch: unexpected n_in %d / ws_size %zu (need %zu)\n", n_in, ws_size, (size_t)WS_END); grid = -1; return; }
        (void)hipGetDevice(&dev);
        (void)hipDeviceGetAttribute(&cus, hipDeviceAttributeMultiprocessorCount, dev);
        if (hipFuncSetAttribute((const void*)fwd, hipFuncAttributeMaxDynamicSharedMemorySize, LDS_BYTES) != hipSuccess) { fprintf(stderr, "kernel_launch: hipFuncSetAttribute failed\n"); grid = -1; return; }
        if (hipOccupancyMaxActiveBlocksPerMultiprocessor(&per_cu, (const void*)fwd, 512, LDS_BYTES) != hipSuccess || per_cu < 1) { fprintf(stderr, "kernel_launch: occupancy query says %d\n", per_cu); per_cu = 1; }
        (void)hipGetLastError();
        grid = cus > 0 ? cus : 256;
    }
    if (grid < 0) return;
    Params p{};
    for (int i = 0; i < 20; ++i) p.in[i] = (const float*)d_in[i];
    p.out = (float*)d_out; p.ws = (unsigned char*)d_ws;
    if (hipMemsetAsync((char*)d_ws + WS_MISC + MISC_BAR, 0, XCD_BAR_WORDS * 4, stream) != hipSuccess) { fprintf(stderr, "kernel_launch: memset of the barrier words failed\n"); return; }
    void* args[] = {&p};
    hipError_t e = hipLaunchCooperativeKernel((const void*)fwd, dim3(grid), dim3(512), args, LDS_BYTES, stream);
    if (e != hipSuccess) fprintf(stderr, "kernel_launch: cooperative launch failed: %s (grid %d)\n", hipGetErrorString(e), grid);
}
```
